# Optimizing an MI355X kernel written in HIP

```python
import math
import jax, jax.numpy as jnp
from jax import lax
import numpy as np

D_MODEL = 2048
BATCH = 4
SEQ = 2048
DEPTH = 4
DEC_BATCH = 32
DEC_SEQ = 8
PAST_LEN = 16384
PAGE_SIZE = 128

HEAD_DIM = 128
N_Q_HEADS = 8
N_KV_HEADS = 2
ATTN_W = N_Q_HEADS * HEAD_DIM
KV_W = N_KV_HEADS * HEAD_DIM
LRU_W = D_MODEL // 2
N_LRU_BLOCKS = 8
LRU_BLOCK = LRU_W // N_LRU_BLOCKS
CONV_W = 4
LRU_C = 8.0
MIX_W = ATTN_W + LRU_W
IN_W = ATTN_W + 2 * KV_W + 2 * LRU_W
D_FF = 4 * D_MODEL
WINDOW = 128
ATTN_BLOCK = WINDOW
N_BUCKETS = 32
MAX_DISTANCE = 128
N_META = 16
EPS = 1e-6

kernel_name = "hymba_griffin_swa_sink_hybrid_step"


def rmsnorm(x, g):
    xf = x.astype(jnp.float32)
    y = xf * lax.rsqrt(jnp.mean(xf * xf, axis=-1, keepdims=True) + EPS)
    return (y * g.astype(jnp.float32)).astype(x.dtype)


def rel_bucket(dist):
    n = jnp.maximum(dist, 0)
    max_exact = N_BUCKETS // 2
    nf = jnp.maximum(n, 1).astype(jnp.float32)
    large = max_exact + (jnp.log(nf / max_exact) / math.log(MAX_DISTANCE / max_exact)
                         * (N_BUCKETS - max_exact)).astype(jnp.int32)
    large = jnp.minimum(large, N_BUCKETS - 1)
    return jnp.where(n < max_exact, n, large)


def sink_attention(q, k, v, q_pos, k_pos, k_valid, sinks, rel_bias):
    B, N, Q, H, D = q.shape
    S = k.shape[2]
    G = H // N_KV_HEADS
    qf = q.astype(jnp.float32).reshape(B, N, Q, N_KV_HEADS, G, D)
    s = jnp.einsum('bnqkgd,bnskd->bnkgqs', qf, k.astype(jnp.float32)) * (D ** -0.5)
    dist = q_pos[:, :, None] - k_pos[:, None, :]
    mask = k_valid[:, None, :] & (dist >= 0) & (dist < WINDOW)
    bias = rel_bias.astype(jnp.float32)[rel_bucket(dist)]
    bias = jnp.transpose(bias, (0, 3, 1, 2)).reshape(N, N_KV_HEADS, G, Q, S)
    s = jnp.where(mask[:, None, None], s + bias[None], -jnp.inf)
    sink = sinks.astype(jnp.float32).reshape(1, 1, N_KV_HEADS, G, 1, 1)
    m = jnp.maximum(jnp.max(s, axis=-1, keepdims=True), sink)
    p = jnp.exp(s - m)
    denom = jnp.sum(p, axis=-1, keepdims=True) + jnp.exp(sink - m)
    o = jnp.einsum('bnkgqs,bnskd->bnqkgd', p / denom, v.astype(jnp.float32))
    return o.reshape(B, N, Q, H, D).astype(q.dtype)


def prompt_window_attention(q, k, v, sinks, rel_bias):
    B, T = q.shape[:2]
    p0 = (-N_META) % ATTN_BLOCK
    nb = -(-(p0 + T) // ATTN_BLOCK)
    p1 = nb * ATTN_BLOCK - p0 - T
    qb = jnp.pad(q, ((0, 0), (p0, p1), (0, 0), (0, 0))).reshape(B, nb, ATTN_BLOCK, N_Q_HEADS, HEAD_DIM)

    def key_blocks(t):
        tp = jnp.pad(t, ((0, 0), (p0 + ATTN_BLOCK, p1), (0, 0), (0, 0)))
        prev = tp[:, :nb * ATTN_BLOCK].reshape(B, nb, ATTN_BLOCK, N_KV_HEADS, HEAD_DIM)
        cur = tp[:, ATTN_BLOCK:].reshape(B, nb, ATTN_BLOCK, N_KV_HEADS, HEAD_DIM)
        return jnp.concatenate([prev, cur], axis=2)

    start = jnp.arange(nb, dtype=jnp.int32)[:, None] * ATTN_BLOCK - p0
    q_pos = start + jnp.arange(ATTN_BLOCK, dtype=jnp.int32)[None]
    k_pos = start - ATTN_BLOCK + jnp.arange(2 * ATTN_BLOCK, dtype=jnp.int32)[None]
    k_valid = (k_pos >= 0) & (k_pos < T)
    o = sink_attention(qb, key_blocks(k), key_blocks(v), q_pos, k_pos, k_valid, sinks, rel_bias)
    return o.reshape(B, nb * ATTN_BLOCK, N_Q_HEADS, HEAD_DIM)[:, p0:p0 + T]


def causal_conv(x, prev, w, b):
    T = x.shape[1]
    xp = jnp.concatenate([prev.astype(x.dtype), x], axis=1)
    out = b.astype(x.dtype) + xp[:, 0:T] * w[0].astype(x.dtype)
    for j in range(1, CONV_W):
        out = out + xp[:, j:j + T] * w[j].astype(x.dtype)
    return out, xp[:, -(CONV_W - 1):]


def rg_lru(x, pos, h0, w_a, b_a, w_x, b_x, lam):
    B, T, _ = x.shape
    xf = x.astype(jnp.float32)
    xb = xf.reshape(B, T, N_LRU_BLOCKS, LRU_BLOCK)
    gate_a = jax.nn.sigmoid(jnp.einsum('btnc,ncd->btnd', xb, w_a.astype(jnp.float32)).reshape(B, T, LRU_W)
                            + b_a.astype(jnp.float32))
    gate_x = jax.nn.sigmoid(jnp.einsum('btnc,ncd->btnd', xb, w_x.astype(jnp.float32)).reshape(B, T, LRU_W)
                            + b_x.astype(jnp.float32))
    log_a = -LRU_C * gate_a * jax.nn.softplus(-lam.astype(jnp.float32))
    a = jnp.exp(log_a)
    mult = jnp.sqrt(-jnp.expm1(2.0 * log_a))
    mult = jnp.where((pos == 0)[None, :, None], 1.0, mult)
    bterm = xf * gate_x * mult
    bterm = bterm.at[:, 0].add(a[:, 0] * h0.astype(jnp.float32))

    def combine(l, r):
        return (l[0] * r[0], r[0] * l[1] + r[1])

    _, h = lax.associative_scan(combine, (a, bterm), axis=1)
    return h, h[:, -1]


def setup_inputs(seed: int = 0) -> dict:
    key = jax.random.key(seed)
    ks = jax.random.split(key, 32)
    f32 = jnp.float32

    def nrm(k, shape, scale):
        return jax.random.normal(k, shape, f32) * scale

    kv_buf = min(WINDOW, PAST_LEN)
    u = jax.random.uniform(ks[15], (DEPTH, LRU_W), f32, 0.9, 0.999)
    a0 = u ** (1.0 / LRU_C)
    lru_lambda = jnp.log(a0) - jnp.log1p(-a0)
    return {
        "x_prompt": nrm(ks[0], (BATCH, SEQ, D_MODEL), 1.0),
        "x_sample": nrm(ks[1], (DEC_BATCH, DEC_SEQ, D_MODEL), 1.0),
        "cache_k_win": nrm(ks[2], (DEPTH, DEC_BATCH, kv_buf, N_KV_HEADS, HEAD_DIM), 1.0),
        "cache_v_win": nrm(ks[3], (DEPTH, DEC_BATCH, kv_buf, N_KV_HEADS, HEAD_DIM), 1.0),
        "state_conv": nrm(ks[4], (DEPTH, DEC_BATCH, CONV_W - 1, LRU_W), 1.0),
        "state_lru": nrm(ks[5], (DEPTH, DEC_BATCH, LRU_W), 0.5),
        "meta_tokens": nrm(ks[6], (N_META, D_MODEL), 1.0),
        "norm_mix_g": 1.0 + nrm(ks[7], (DEPTH, D_MODEL), 0.02),
        "w_in": nrm(ks[8], (DEPTH, D_MODEL, IN_W), D_MODEL ** -0.5),
        "conv_w": nrm(ks[9], (DEPTH, CONV_W, LRU_W), CONV_W ** -0.5),
        "conv_b": nrm(ks[10], (DEPTH, LRU_W), 0.01),
        "w_gate_a": nrm(ks[11], (DEPTH, N_LRU_BLOCKS, LRU_BLOCK, LRU_BLOCK), LRU_BLOCK ** -0.5),
        "b_gate_a": nrm(ks[12], (DEPTH, LRU_W), 0.01),
        "w_gate_x": nrm(ks[13], (DEPTH, N_LRU_BLOCKS, LRU_BLOCK, LRU_BLOCK), LRU_BLOCK ** -0.5),
        "b_gate_x": nrm(ks[14], (DEPTH, LRU_W), 0.01),
        "lru_lambda": lru_lambda,
        "attn_sinks": nrm(ks[16], (DEPTH, N_Q_HEADS), 1.0),
        "rel_bias": nrm(ks[17], (N_BUCKETS, N_Q_HEADS), 0.5),
        "attn_out_g": 1.0 + nrm(ks[18], (DEPTH, ATTN_W), 0.02),
        "rec_out_g": 1.0 + nrm(ks[19], (DEPTH, LRU_W), 0.02),
        "w_out": nrm(ks[20], (DEPTH, MIX_W, D_MODEL), MIX_W ** -0.5),
        "norm_mlp_g": 1.0 + nrm(ks[21], (DEPTH, D_MODEL), 0.02),
        "w_up": nrm(ks[22], (DEPTH, D_MODEL, D_FF), D_MODEL ** -0.5),
        "w_down": nrm(ks[23], (DEPTH, D_FF, D_MODEL), D_FF ** -0.5),
        "final_norm_g": 1.0 + nrm(ks[24], (D_MODEL,), 0.02),
    }


def reference(x_prompt, x_sample, cache_k_win, cache_v_win, state_conv, state_lru,
              meta_tokens, norm_mix_g, w_in, conv_w, conv_b, w_gate_a, b_gate_a, w_gate_x, b_gate_x,
              lru_lambda, attn_sinks, rel_bias, attn_out_g, rec_out_g, w_out, norm_mlp_g, w_up, w_down,
              final_norm_g):
    split_at = [ATTN_W, ATTN_W + KV_W, ATTN_W + 2 * KV_W, ATTN_W + 2 * KV_W + LRU_W]

    def layer(h, l, pos, attend, conv_prev, lru_prev):
        B, T = h.shape[:2]
        u = rmsnorm(h, norm_mix_g[l])
        z = u @ w_in[l]
        q, k, v, xr, gr = jnp.split(z, split_at, axis=-1)
        q = q.reshape(B, T, N_Q_HEADS, HEAD_DIM)
        k = k.reshape(B, T, N_KV_HEADS, HEAD_DIM)
        v = v.reshape(B, T, N_KV_HEADS, HEAD_DIM)
        attn, k_buf, v_buf = attend(q, k, v, l)
        xc, conv_new = causal_conv(xr, conv_prev, conv_w[l], conv_b[l])
        hr, lru_new = rg_lru(xc, pos, lru_prev, w_gate_a[l], b_gate_a[l], w_gate_x[l], b_gate_x[l],
                             lru_lambda[l])
        rec = (hr * jax.nn.gelu(gr.astype(jnp.float32))).astype(h.dtype)
        mixed = jnp.concatenate([rmsnorm(attn.reshape(B, T, ATTN_W), attn_out_g[l]),
                                 rmsnorm(rec, rec_out_g[l])], axis=-1)
        h = h + mixed @ w_out[l]
        hid = jnp.square(jax.nn.relu(rmsnorm(h, norm_mlp_g[l]) @ w_up[l]))
        h = h + hid @ w_down[l]
        return h, k_buf, v_buf, conv_new, lru_new.astype(h.dtype)

    def attend_prompt(q, k, v, l):
        o = prompt_window_attention(q, k, v, attn_sinks[l], rel_bias)
        return o, k[:, -WINDOW:], v[:, -WINDOW:]

    def attend_sample(q, k, v, l):
        kk = jnp.concatenate([cache_k_win[l].astype(k.dtype), k], axis=1)
        vv = jnp.concatenate([cache_v_win[l].astype(v.dtype), v], axis=1)
        buf = cache_k_win.shape[2]
        T = q.shape[1]
        q_pos = (PAST_LEN + jnp.arange(T, dtype=jnp.int32))[None]
        k_pos = (PAST_LEN - buf + jnp.arange(buf + T, dtype=jnp.int32))[None]
        o = sink_attention(q[:, None], kk[:, None], vv[:, None], q_pos, k_pos, k_pos >= 0,
                           attn_sinks[l], rel_bias)
        return o[:, 0], kk[:, -buf:], vv[:, -buf:]

    meta = jnp.broadcast_to(meta_tokens.astype(x_prompt.dtype)[None], (x_prompt.shape[0], N_META, D_MODEL))
    hp = jnp.concatenate([meta, x_prompt], axis=1)
    Bp, Tp = hp.shape[:2]
    pos_p = jnp.arange(Tp, dtype=jnp.int32)
    conv0 = jnp.zeros((Bp, CONV_W - 1, LRU_W), hp.dtype)
    lru0 = jnp.zeros((Bp, LRU_W), jnp.float32)

    hs = x_sample
    pos_s = PAST_LEN + jnp.arange(x_sample.shape[1], dtype=jnp.int32)

    kp_l, vp_l, cp_l, lp_l = [], [], [], []
    ks_l, vs_l, cs_l, ls_l = [], [], [], []
    for l in range(DEPTH):
        hp, kb, vb, cb, lb = layer(hp, l, pos_p, attend_prompt, conv0, lru0)
        kp_l.append(kb); vp_l.append(vb); cp_l.append(cb); lp_l.append(lb)
        hs, kb, vb, cb, lb = layer(hs, l, pos_s, attend_sample, state_conv[l], state_lru[l])
        ks_l.append(kb); vs_l.append(vb); cs_l.append(cb); ls_l.append(lb)

    y_prompt = rmsnorm(hp, final_norm_g)[:, N_META:]
    y_sample = rmsnorm(hs, final_norm_g)
    return (y_prompt, y_sample,
            jnp.stack(kp_l), jnp.stack(vp_l), jnp.stack(cp_l), jnp.stack(lp_l),
            jnp.stack(ks_l), jnp.stack(vs_l), jnp.stack(cs_l), jnp.stack(ls_l))
```

```cpp
#include <hip/hip_runtime.h>
#include <hip/hip_cooperative_groups.h>
#include <cstdio>
#include <cstdint>
namespace cg = cooperative_groups;

#ifndef MK_SINGLE
#define MK_SINGLE 1
#endif

#define LAS __attribute__((address_space(3)))
typedef unsigned short bf16_t;
typedef short bf16x8 __attribute__((ext_vector_type(8)));
typedef short bf16x4 __attribute__((ext_vector_type(4)));
typedef float f32x4 __attribute__((ext_vector_type(4)));
typedef unsigned u32x4 __attribute__((ext_vector_type(4)));
typedef unsigned u32x2 __attribute__((ext_vector_type(2)));

constexpr int D = 2048, NB = 4, SEQ = 2048, NMETA = 16, TP = SEQ + NMETA, DEPTH = 4, DBAT = 32, DSEQ = 8;
constexpr int MP = NB * TP, MS = DBAT * DSEQ, MV = MP + MS, MPAD = 8704;
constexpr int INW = 3584, DFF = 8192, LRUW = 1024, ATTW = 1024, NGRP = TP / 16  ;
constexpr int ZQ = 0, ZK = 1024, ZV = 1280, ZX = 1536, ZG = 2560;
constexpr float EPS = 1e-6f;
constexpr int NTHREADS = 512, NWAVES = 8;
constexpr int LDS_BYTES = 150 * 1024;
constexpr int XCD_BAR_WORDS_C = 3456;

constexpr size_t al256(size_t x) { return (x + 255) & ~(size_t)255; }
constexpr size_t WS_WIN = 0;
constexpr size_t WS_WOUT = WS_WIN + (size_t)DEPTH * INW * D * 2;
constexpr size_t WS_WUP = WS_WOUT + (size_t)DEPTH * D * D * 2;
constexpr size_t WS_WDN = WS_WUP + (size_t)DEPTH * DFF * D * 2;
constexpr size_t WS_WG = WS_WDN + (size_t)DEPTH * D * DFF * 2;
constexpr size_t WS_H = WS_WG + (size_t)DEPTH * 2 * 8 * 128 * 128 * 2;
constexpr size_t WS_U = WS_H + (size_t)MPAD * D * 4;
constexpr size_t WS_Z = WS_U + (size_t)MPAD * D * 2;
constexpr size_t WS_ATT = WS_Z + (size_t)MPAD * INW * 4;
constexpr size_t WS_HLOC = WS_ATT + (size_t)MPAD * ATTW * 4;
constexpr size_t WS_ACUM = WS_HLOC + (size_t)MPAD * LRUW * 4;
constexpr size_t WS_AGGA = WS_ACUM + (size_t)MPAD * LRUW * 4;
constexpr size_t WS_AGGH = WS_AGGA + (size_t)NB * NGRP * LRUW * 4;
constexpr size_t WS_AG64A = WS_AGGH + (size_t)NB * NGRP * LRUW * 4;
constexpr size_t WS_AG64H = WS_AG64A + (size_t)NB * 33 * LRUW * 4;
constexpr size_t WS_MIX = WS_AG64H + (size_t)NB * 33 * LRUW * 4;
constexpr size_t WS_HID = WS_MIX + (size_t)MPAD * D * 2;
constexpr size_t WS_PART = WS_HID + (size_t)MPAD * DFF * 2;
constexpr size_t WS_H2 = WS_PART + (size_t)16 * 512 * 2048 * 4;
constexpr size_t WS_BAR = WS_H2 + (size_t)MPAD * D * 4;
constexpr size_t WS_END = WS_BAR + 256 + XCD_BAR_WORDS_C * 4;

constexpr size_t O_YP = 0;
constexpr size_t O_YS = O_YP + (size_t)NB * SEQ * D;
constexpr size_t O_KP = O_YS + (size_t)MS * D;
constexpr size_t O_VP = O_KP + (size_t)DEPTH * NB * 128 * 256;
constexpr size_t O_CP = O_VP + (size_t)DEPTH * NB * 128 * 256;
constexpr size_t O_LP = O_CP + (size_t)DEPTH * NB * 3 * LRUW;
constexpr size_t O_KS = O_LP + (size_t)DEPTH * NB * LRUW;
constexpr size_t O_VS = O_KS + (size_t)DEPTH * DBAT * 128 * 256;
constexpr size_t O_CS = O_VS + (size_t)DEPTH * DBAT * 128 * 256;
constexpr size_t O_LS = O_CS + (size_t)DEPTH * DBAT * 3 * LRUW;
constexpr size_t O_END = O_LS + (size_t)DEPTH * DBAT * LRUW;

struct Params;
typedef const Params __attribute__((address_space(4))) PRM;
struct Params {
    const float* in[25];
    float* out;
    unsigned char* ws;
    int ph_lo, ph_hi;
};

__device__ __forceinline__ unsigned f2bf(float f) { unsigned u = __builtin_bit_cast(unsigned, f); return (u + 0x7fffu + ((u >> 16) & 1u)) >> 16; }
__device__ __forceinline__ unsigned f2bf_hw(float f) { unsigned r; asm("v_cvt_pk_bf16_f32 %0, %1, %1" : "=v"(r) : "v"(f)); return r & 0xffffu; }
__device__ __forceinline__ unsigned pk2(float lo, float hi) { unsigned r; asm("v_cvt_pk_bf16_f32 %0, %1, %2" : "=v"(r) : "v"(lo), "v"(hi)); return r; }
__device__ __forceinline__ float shx(float v, int lane, int o) { return __builtin_bit_cast(float, __builtin_amdgcn_ds_bpermute((lane ^ o) << 2, __builtin_bit_cast(int, v))); }
__device__ __forceinline__ float wave_sum(float v, int lane) {
#pragma unroll
    for (int o = 1; o < 64; o <<= 1) v += shx(v, lane, o);
    return v;
}
__device__ __forceinline__ int otid() { int t = threadIdx.x; asm volatile("" : "+v"(t)); return t; }
__device__ __forceinline__ float bflo(unsigned w) { return __builtin_bit_cast(float, w << 16); }
__device__ __forceinline__ float bfhi(unsigned w) { return __builtin_bit_cast(float, w & 0xffff0000u); }
__device__ __forceinline__ float bf2f(bf16_t v) { return __builtin_bit_cast(float, (unsigned)v << 16); }
__device__ __forceinline__ f32x4 bf4(u32x2 w) { return (f32x4){bflo(w.x), bfhi(w.x), bflo(w.y), bfhi(w.y)}; }
#define LDS_WAIT() asm volatile("s_waitcnt lgkmcnt(0)" ::: "memory")

namespace pg8 {
constexpr int BM = 256, BK = 64, HALF = 128, HTB = HALF * BK * 2, STAGE_BYTES = 8 * HTB, NXCD = 8, WGM = 8;
__host__ __device__ __forceinline__ int lds_byte(int r, int c) { const int st = (r >> 4) * 2 + (c >> 5), rr = r & 15, cc = c & 31, ob = rr * 64 + cc * 2; return st * 1024 + (ob ^ (((ob >> 9) & 1) << 5)); }
__host__ __device__ __forceinline__ void stage_rc(int b, int& R, int& C) { const int st = b / 1024, sb = b % 1024, swz = sb ^ (((sb >> 9) & 1) << 5); R = (st >> 1) * 16 + swz / 64; C = (st & 1) * 32 + (swz % 64) / 2; }
__host__ __device__ __forceinline__ int perm32(int rho) { const int n = rho >> 4, i = rho & 15; return 8 * (i >> 2) + 4 * n + (i & 3); }

struct Unit { int pm, pn, k0, nkt, part; };
struct Gemm { const bf16_t* A; const bf16_t* Bt; int M, N, K; };

struct StaticOrder {
    int nM, nN, nwg, G, c;
    __host__ __device__ void init(int M, int N, int G_, int c_) { nM = M / BM; nN = N / BM; nwg = nM * nN; G = G_; c = c_; }
    __host__ __device__ bool next(int i, Unit& u) const {
        const long L = (long)i * G + c; if (L >= nwg) return false;
        int wgid = (int)L; { const int q = nwg / NXCD, r = nwg % NXCD, xcd = wgid % NXCD, off = wgid / NXCD; wgid = (xcd < r ? xcd * (q + 1) : r * (q + 1) + (xcd - r) * q) + off; }
        const int nig = WGM * nN, gid = wgid / nig, fm = gid * WGM, gsz = (nM - fm) < WGM ? (nM - fm) : WGM;
        u.pm = fm + ((wgid % nig) % gsz); u.pn = (wgid % nig) / gsz; return true;
    }
};
struct TailOrder {
    StaticOrder so; int nkt, S, c;
    __host__ __device__ void init(int M, int N, int K, int G, int c_, bool split) {
        nkt = K / BK; c = c_; S = 1;
        if (split && M == 34 * BM && N == 8 * BM && G == 256) S = nkt >= 128 ? 16 : 8;
        so.init(S == 1 ? M : 32 * BM, N, G, c_);
    }
    __host__ __device__ bool next(int i, Unit& u) const {
        u.k0 = 0; u.nkt = nkt; u.part = -1;
        if (S == 1 || i == 0) return so.next(i, u);
        if (i != 1 || c >= 16 * S) return false;
        const int x = c & 7, y = c >> 3, r = S >> 3, sp = x + 8 * (y % r), j = y / r;
        u.pm = 32 + (j >> 3); u.pn = j & 7; u.nkt = nkt / S; u.k0 = sp * u.nkt; u.part = sp; return true;
    }
    __device__ __forceinline__ void a_ready(const Unit&) const {}
    __device__ __forceinline__ void done(const Unit&) const {}
};

struct Epi {
    int mode; void* C; int ldc; float* part; const bf16_t* R;
    __device__ __forceinline__ void operator()(const f32x4 (&acc)[2][2][4][2], const Unit& u, int wr, int wc, int fr, int fq) const {
        if (u.part >= 0) {
            const int row0 = (u.pm - 32) * BM + wr * 64 + fr, col0 = u.pn * BM + wc * 32 + 8 * fq;
            bf16_t* P = (bf16_t*)part + (size_t)u.part * (512 * 2048);
#pragma unroll
            for (int ai = 0; ai < 2; ++ai)
#pragma unroll
                for (int m = 0; m < 4; ++m) { bf16_t* rowp = P + (size_t)(row0 + ai * HALF + m * 16) * 2048 + col0;
#pragma unroll
                    for (int bj = 0; bj < 2; ++bj) { const f32x4 v0 = acc[ai][bj][m][0], v1 = acc[ai][bj][m][1];
                        u32x4 o; o.x = pk2(v0[0], v0[1]); o.y = pk2(v0[2], v0[3]); o.z = pk2(v1[0], v1[1]); o.w = pk2(v1[2], v1[3]);
                        *(u32x4*)(rowp + bj * HALF) = o; } }
            return;
        }
        const int row0 = u.pm * BM + wr * 64 + fr;
        if (mode >= 1) {
            const bool act = mode == 2;
            const int col0 = u.pn * BM + wc * 32 + 8 * fq;
#pragma unroll
            for (int ai = 0; ai < 2; ++ai)
#pragma unroll
                for (int m = 0; m < 4; ++m) { bf16_t* rowp = (bf16_t*)C + (size_t)(row0 + ai * HALF + m * 16) * ldc + col0;
#pragma unroll
                    for (int bj = 0; bj < 2; ++bj) { f32x4 v0 = acc[ai][bj][m][0], v1 = acc[ai][bj][m][1];
                        if (mode == 1) { const u32x4 rr = *(const u32x4*)(R + (size_t)(row0 + ai * HALF + m * 16) * ldc + col0 + bj * HALF);
                            v0 += (f32x4){bflo(rr.x), bfhi(rr.x), bflo(rr.y), bfhi(rr.y)}; v1 += (f32x4){bflo(rr.z), bfhi(rr.z), bflo(rr.w), bfhi(rr.w)}; }
#pragma unroll
                        for (int e = 0; e < 4; ++e) { float a = fmaxf(v0[e], 0.f), b = fmaxf(v1[e], 0.f); v0[e] = act ? a * a : v0[e]; v1[e] = act ? b * b : v1[e]; }
                        u32x4 o; o.x = pk2(v0[0], v0[1]); o.y = pk2(v0[2], v0[3]); o.z = pk2(v1[0], v1[1]); o.w = pk2(v1[2], v1[3]);
                        *(u32x4*)(rowp + bj * HALF) = o; } }
        } else {
            const int col0 = u.pn * BM + wc * 32 + 4 * fq;
            const bool add = mode == 1;
#pragma unroll
            for (int ai = 0; ai < 2; ++ai)
#pragma unroll
                for (int m = 0; m < 4; ++m) { float* rowp = (float*)C + (size_t)(row0 + ai * HALF + m * 16) * ldc + col0;
                    f32x4 old[2][2];
#pragma unroll
                    for (int bj = 0; bj < 2; ++bj)
#pragma unroll
                        for (int n = 0; n < 2; ++n) old[bj][n] = add ? *(const f32x4*)(R + (size_t)(row0 + ai * HALF + m * 16) * ldc + col0 + bj * HALF + n * 16) : (f32x4){0.f, 0.f, 0.f, 0.f};
#pragma unroll
                    for (int bj = 0; bj < 2; ++bj)
#pragma unroll
                        for (int n = 0; n < 2; ++n) *(f32x4*)(rowp + bj * HALF + n * 16) = acc[ai][bj][m][n] + old[bj][n]; }
        }
    }
};

template <class Sched>
__device__ __forceinline__ void gemm_phase(LAS unsigned char* lds, const Gemm g, const Sched& S, const Epi& E) {
    const int tid = otid(), wid = __builtin_amdgcn_readfirstlane(tid >> 6), lane = tid & 63, wr = wid >> 2, wc = wid & 3, fr = lane & 15, fq = lane >> 4;
    const int K = g.K;
    unsigned voffA[2], voffB[2];
#pragma unroll
    for (int i = 0; i < 2; ++i) { int R, C; stage_rc(tid * 16 + i * 8192, R, C); const int Rb = (E.mode >= 1) ? ((R & ~31) + perm32(R & 31)) : R;
        voffA[i] = (unsigned)(R * K + C) * 2u; voffB[i] = (unsigned)(Rb * K + C) * 2u; }
    const size_t kstep = (size_t)(BK * 2);
    const size_t hstep = (size_t)HALF * K * 2;
    const size_t tstep = 2 * hstep;
    const unsigned ldsw = (unsigned)wid * 1024u;
    const int aoff = lds_byte(wr * 64 + fr, fq * 8), boff = lds_byte(wc * 32 + fr, fq * 8);
#define PG8_SA(b, h) (((b) * 2 + (h)) * HTB)
#define PG8_SB(b, h) ((4 + (b) * 2 + (h)) * HTB)
#define PG8_STAGE(bufoff, gbase, voff) do { _Pragma("unroll") for (int _i = 0; _i < 2; ++_i) \
        __builtin_amdgcn_global_load_lds((const unsigned*)((const char*)(gbase) + (voff)[_i]), (LAS unsigned*)(lds + (bufoff) + ldsw + _i * 8192), 16, 0, 0); } while (0)
#define PG8_LDA(dst, b, h) do { _Pragma("unroll") for (int m = 0; m < 4; ++m) _Pragma("unroll") for (int k = 0; k < 2; ++k) dst[m][k] = *(const LAS bf16x8*)(lds + PG8_SA(b, h) + aoff + m * 2048 + k * 1024); } while (0)
#define PG8_LDB(dst, b, h) do { _Pragma("unroll") for (int n = 0; n < 2; ++n) _Pragma("unroll") for (int k = 0; k < 2; ++k) dst[n][k] = *(const LAS bf16x8*)(lds + PG8_SB(b, h) + boff + n * 2048 + k * 1024); } while (0)
#define PG8_MMA(ai, bj, At, Bt) do { __builtin_amdgcn_s_setprio(1); _Pragma("unroll") for (int m = 0; m < 4; ++m) _Pragma("unroll") for (int n = 0; n < 2; ++n) _Pragma("unroll") for (int k = 0; k < 2; ++k) \
        acc[ai][bj][m][n] = __builtin_amdgcn_mfma_f32_16x16x32_bf16(Bt[n][k], At[m][k], acc[ai][bj][m][n], 0, 0, 0); __builtin_amdgcn_s_setprio(0); } while (0)
#define PG8_WAIT_V(n) asm volatile("s_waitcnt vmcnt(" #n ")" ::: "memory")
#define PG8_WAIT_L(n) asm volatile("s_waitcnt lgkmcnt(" #n ")" ::: "memory")
#define PG8_BAR __builtin_amdgcn_s_barrier()
#define PG8_SCHED __builtin_amdgcn_sched_barrier(0)
    Unit cur, nxt; int ui = 0;
    if (!S.next(0, cur)) return;
    f32x4 acc[2][2][4][2];
#pragma unroll
    for (int a = 0; a < 2; ++a)
#pragma unroll
        for (int b = 0; b < 2; ++b)
#pragma unroll
            for (int m = 0; m < 4; ++m)
#pragma unroll
                for (int n = 0; n < 2; ++n) acc[a][b][m][n] = (f32x4){0.f, 0.f, 0.f, 0.f};
    bf16x8 At[4][2], B0[2][2], B1[2][2];
    const char* cA = (const char*)g.A + (size_t)cur.pm * tstep + (size_t)cur.k0 * kstep; const char* cB = (const char*)g.Bt + (size_t)cur.pn * tstep + (size_t)cur.k0 * kstep;
    S.a_ready(cur);
    PG8_STAGE(PG8_SB(0, 0), cB, voffB); PG8_STAGE(PG8_SB(0, 1), cB + hstep, voffB); PG8_STAGE(PG8_SA(0, 0), cA, voffA); PG8_STAGE(PG8_SA(0, 1), cA + hstep, voffA);
    if (wr == 1) PG8_BAR;
    PG8_WAIT_V(2); PG8_BAR;
    PG8_STAGE(PG8_SB(1, 0), cB + kstep, voffB); PG8_STAGE(PG8_SA(1, 0), cA + kstep, voffA); PG8_STAGE(PG8_SB(1, 1), cB + hstep + kstep, voffB);
    PG8_WAIT_V(6); PG8_BAR;
    for (;;) {
        const bool has_next = S.next(ui + 1, nxt);
        const char* nA = has_next ? (const char*)g.A + (size_t)nxt.pm * tstep + (size_t)nxt.k0 * kstep : cA; const char* nB = has_next ? (const char*)g.Bt + (size_t)nxt.pn * tstep + (size_t)nxt.k0 * kstep : cB;
        const int nt = cur.nkt;
        for (int t = 0; t < nt; t += 2) {
            const bool last = (t == nt - 2);
            const char* a1 = cA + (size_t)(t + 1) * kstep;
            const char* a2 = last ? nA : cA + (size_t)(t + 2) * kstep; const char* b2 = last ? nB : cB + (size_t)(t + 2) * kstep;
            const char* a3 = a2 + kstep; const char* b3 = b2 + kstep;
            if (last && has_next) S.a_ready(nxt);
            PG8_LDB(B0, 0, 0); PG8_LDB(B1, 0, 1); PG8_SCHED; PG8_LDA(At, 0, 0); PG8_STAGE(PG8_SA(1, 1), a1 + hstep, voffA);
            PG8_WAIT_V(8); PG8_WAIT_L(0); PG8_BAR; PG8_MMA(0, 0, At, B0); PG8_MMA(0, 1, At, B1); PG8_BAR; PG8_SCHED;
            PG8_LDA(At, 0, 1); PG8_STAGE(PG8_SB(0, 0), b2, voffB); PG8_STAGE(PG8_SB(0, 1), b2 + hstep, voffB); PG8_STAGE(PG8_SA(0, 0), a2, voffA);
            PG8_WAIT_V(8); PG8_WAIT_L(0); PG8_BAR; PG8_MMA(1, 0, At, B0); PG8_MMA(1, 1, At, B1); PG8_BAR; PG8_SCHED;
            PG8_LDB(B0, 1, 0); PG8_LDB(B1, 1, 1); PG8_SCHED; PG8_LDA(At, 1, 0); PG8_STAGE(PG8_SA(0, 1), a2 + hstep, voffA);
            PG8_WAIT_V(8); PG8_WAIT_L(0); PG8_BAR; PG8_MMA(0, 0, At, B0); PG8_MMA(0, 1, At, B1); PG8_BAR; PG8_SCHED;
            PG8_LDA(At, 1, 1); PG8_STAGE(PG8_SB(1, 0), b3, voffB); PG8_STAGE(PG8_SB(1, 1), b3 + hstep, voffB); PG8_STAGE(PG8_SA(1, 0), a3, voffA);
            PG8_WAIT_V(8); PG8_WAIT_L(0); PG8_BAR; PG8_MMA(1, 0, At, B0); PG8_MMA(1, 1, At, B1); PG8_BAR; PG8_SCHED;
        }
        if (wr == 0) PG8_BAR;
        E(acc, cur, wr, wc, fr, fq); S.done(cur);
        if (!has_next) break;
#pragma unroll
        for (int a = 0; a < 2; ++a)
#pragma unroll
            for (int b = 0; b < 2; ++b)
#pragma unroll
                for (int m = 0; m < 4; ++m)
#pragma unroll
                    for (int n = 0; n < 2; ++n) acc[a][b][m][n] = (f32x4){0.f, 0.f, 0.f, 0.f};
        cur = nxt; cA = nA; cB = nB; ++ui;
        if (wr == 1) PG8_BAR;
    }
    PG8_WAIT_V(0);
    PG8_BAR;
#undef PG8_SA
#undef PG8_SB
#undef PG8_STAGE
#undef PG8_LDA
#undef PG8_LDB
#undef PG8_MMA
#undef PG8_WAIT_V
#undef PG8_WAIT_L
#undef PG8_BAR
#undef PG8_SCHED
}
}

struct TItem { const float* W; const float* g0; const float* g1; bf16_t* WT; int K, N, k0, n0; };
__device__ __forceinline__ TItem prep_item(PRM& p, int it) {
    constexpr int I_IN = (D / 64) * (INW / 256), I_OUT = (D / 64) * (D / 256), I_UP = (D / 64) * (DFF / 256), I_DN = (DFF / 64) * (D / 256);
    constexpr int PER_L = I_IN + I_OUT + I_UP + I_DN;
    const int l = it / PER_L; int r = it % PER_L; TItem t;
    if (r < I_IN) { t.W = p.in[8] + (size_t)l * D * INW; t.g0 = p.in[7] + l * D; t.g1 = nullptr; t.WT = (bf16_t*)(p.ws + WS_WIN) + (size_t)l * INW * D; t.K = D; t.N = INW; }
    else if ((r -= I_IN) < I_OUT) { t.W = p.in[20] + (size_t)l * D * D; t.g0 = p.in[18] + l * ATTW; t.g1 = p.in[19] + l * LRUW; t.WT = (bf16_t*)(p.ws + WS_WOUT) + (size_t)l * D * D; t.K = D; t.N = D; }
    else if ((r -= I_OUT) < I_UP) { t.W = p.in[22] + (size_t)l * D * DFF; t.g0 = p.in[21] + l * D; t.g1 = nullptr; t.WT = (bf16_t*)(p.ws + WS_WUP) + (size_t)l * DFF * D; t.K = D; t.N = DFF; }
    else { r -= I_UP; t.W = p.in[23] + (size_t)l * DFF * D; t.g0 = nullptr; t.g1 = nullptr; t.WT = (bf16_t*)(p.ws + WS_WDN) + (size_t)l * D * DFF; t.K = DFF; t.N = D; }
    const int nblk = t.N / 256; t.k0 = 64 * (r / nblk); t.n0 = 256 * (r % nblk);
    return t;
}
__device__ __forceinline__ void prep_load(const TItem& t, int wave, int lane, f32x4 (&v)[8]) {
#pragma unroll
    for (int r = 0; r < 8; ++r) { const int k = t.k0 + 8 * wave + r; v[r] = *(const f32x4*)(t.W + (size_t)k * t.N + t.n0 + 4 * lane); }
}
constexpr int PREP_ITEMS = DEPTH * ((D / 64) * (INW / 256) + (D / 64) * (D / 256) + (D / 64) * (DFF / 256) + (DFF / 64) * (D / 256));

__device__ __forceinline__ void prep_transposes(PRM& p, LAS unsigned char* lds, int it0, int it1, int w, int nw) {
    const int tid = otid(), lane = tid & 63, wave = tid >> 6;
    LAS float* tile = (LAS float*)lds;
    int it = it0 + w;
    f32x4 v[8];
    TItem cur = prep_item(p, it < it1 ? it : it0);
    if (it < it1) prep_load(cur, wave, lane, v);
    for (; it < it1; it += nw) {
#pragma unroll
        for (int r = 0; r < 8; ++r) { const int kk = 8 * wave + r, k = cur.k0 + kk;
            float sc = 1.f; if (cur.g0) sc = (cur.g1 && k >= 1024) ? cur.g1[k - 1024] : cur.g0[k];
            *(LAS f32x4*)(tile + kk * 260 + 4 * lane) = v[r] * sc; }
        __syncthreads();
        const TItem me = cur;
        const int nit = it + nw;
        if (nit < it1) { cur = prep_item(p, nit); prep_load(cur, wave, lane, v); }
#pragma unroll
        for (int j = 0; j < 4; ++j) { const int pair = j * 512 + tid, n = pair >> 3, c = pair & 7; const LAS float* sp = tile + (8 * c) * 260 + n;
            u32x4 o; o.x = pk2(sp[0 * 260], sp[1 * 260]); o.y = pk2(sp[2 * 260], sp[3 * 260]); o.z = pk2(sp[4 * 260], sp[5 * 260]); o.w = pk2(sp[6 * 260], sp[7 * 260]);
            *(u32x4*)(me.WT + (size_t)(me.n0 + n) * me.K + me.k0 + 8 * c) = o; }
        __syncthreads();
    }
}
constexpr int PREP_PER_L = PREP_ITEMS / DEPTH;
__device__ __forceinline__ void phase_prep(PRM& p, LAS unsigned char* lds) {
    const int tid = otid(), lane = tid & 63, wave = tid >> 6;
    prep_transposes(p, lds, 0, gridDim.x == 256 ? PREP_PER_L : PREP_ITEMS, blockIdx.x, gridDim.x);
    const size_t gt = (size_t)blockIdx.x * NTHREADS + tid, GT = (size_t)gridDim.x * NTHREADS;
    {
        LAS float* tl = (LAS float*)lds;
        bf16_t* wg = (bf16_t*)(p.ws + WS_WG);
        for (int m = blockIdx.x; m < DEPTH * 2 * 8; m += gridDim.x) {
            const int blk = m & 7, gate = (m >> 3) & 1, l = m >> 4;
            const f32x4* src = (const f32x4*)((gate ? p.in[13] : p.in[11]) + ((size_t)l * 8 + blk) * 16384);
            __syncthreads();
#pragma unroll
            for (int k = 0; k < 8; ++k) { const int i4 = tid + k * NTHREADS, c = i4 >> 5, d = (i4 & 31) * 4; const f32x4 v = src[i4];
                tl[c * 129 + d] = v.x; tl[c * 129 + d + 1] = v.y; tl[c * 129 + d + 2] = v.z; tl[c * 129 + d + 3] = v.w; }
            __syncthreads();
            unsigned* dst = (unsigned*)(wg + (size_t)m * 16384);
#pragma unroll
            for (int k = 0; k < 16; ++k) { const int o = tid + k * NTHREADS, d = o >> 6, c2 = (o & 63) * 2; dst[o] = pk2(tl[c2 * 129 + d], tl[(c2 + 1) * 129 + d]); }
        }
        __syncthreads();
    }
    {
        const int gw = blockIdx.x * NWAVES + wave, NGW = gridDim.x * NWAVES;
        for (int row = gw; row < MPAD; row += NGW) {
            const float* src = nullptr;
            if (row < MP) { const int b = row / TP, t = row % TP; src = t < NMETA ? p.in[6] + (size_t)t * D : p.in[0] + ((size_t)b * SEQ + (t - NMETA)) * D; }
            else if (row < MV) src = p.in[1] + (size_t)(row - MP) * D;
            f32x4 v[8]; float sq = 0.f;
#pragma unroll
            for (int j = 0; j < 8; ++j) { v[j] = src ? *(const f32x4*)(src + j * 256 + lane * 4) : (f32x4){0.f, 0.f, 0.f, 0.f}; sq += (v[j].x * v[j].x + v[j].y * v[j].y) + (v[j].z * v[j].z + v[j].w * v[j].w); }
#pragma unroll
            for (int j = 0; j < 8; ++j) { u32x2 w; w.x = pk2(v[j].x, v[j].y); w.y = pk2(v[j].z, v[j].w); *(u32x2*)((bf16_t*)(p.ws + WS_H) + (size_t)row * D + j * 256 + lane * 4) = w; }
            if (row < MV) { const float rs = 1.f / sqrtf(wave_sum(sq, lane) * (1.f / D) + EPS);
#pragma unroll
                for (int j = 0; j < 8; ++j) { u32x2 w; w.x = pk2(v[j].x * rs, v[j].y * rs); w.y = pk2(v[j].z * rs, v[j].w * rs); *(u32x2*)((bf16_t*)(p.ws + WS_U) + (size_t)row * D + j * 256 + lane * 4) = w; } }
        }
    }
    { u32x4 z4 = (u32x4){0u, 0u, 0u, 0u};
      u32x4* u4 = (u32x4*)(p.ws + WS_U) + (size_t)MV * (D / 8); for (size_t i = gt; i < (size_t)(MPAD - MV) * (D / 8); i += GT) u4[i] = z4;
      u32x4* m4 = (u32x4*)(p.ws + WS_MIX) + (size_t)MV * (D / 8); for (size_t i = gt; i < (size_t)(MPAD - MV) * (D / 8); i += GT) m4[i] = z4;
      u32x4* d4 = (u32x4*)(p.ws + WS_HID) + (size_t)MV * (DFF / 8); for (size_t i = gt; i < (size_t)(MPAD - MV) * (DFF / 8); i += GT) d4[i] = z4; }
}

__device__ __forceinline__ void norm_out(PRM& p, bool final_, int row, int col, f32x4 v, float rstd) {
    if (!final_) { u32x2 w; w.x = pk2(v.x * rstd, v.y * rstd); w.y = pk2(v.z * rstd, v.w * rstd); *(u32x2*)((bf16_t*)(p.ws + WS_U) + (size_t)row * D + col) = w; }
    else { float* dst = nullptr;
        if (row < MP) { const int b = row / TP, t = row % TP; if (t >= NMETA) dst = p.out + O_YP + ((size_t)b * SEQ + (t - NMETA)) * D; }
        else dst = p.out + O_YS + (size_t)(row - MP) * D;
        if (dst) { const f32x4 g = *(const f32x4*)(p.in[24] + col); *(f32x4*)(dst + col) = v * rstd * g; } }
}
__device__ __forceinline__ void phase_norm(PRM& p, bool final_, int nparts, size_t h_in, size_t h_out, LAS unsigned char* lds) {
    const int tid = otid(), lane = tid & 63, wave = tid >> 6;
    const int gw = blockIdx.x * NWAVES + wave, NGW = gridDim.x * NWAVES;
    const bf16_t* H = (const bf16_t*)(p.ws + h_out); const bf16_t* Hin = (const bf16_t*)(p.ws + (nparts > 0 ? h_in : h_out));
    constexpr int MAIN = 32 * 256;
    LAS float* red = (LAS float*)lds;
    for (int tr = blockIdx.x; tr < MV - MAIN; tr += gridDim.x) {
        const int row = MAIN + tr, col = wave * 256 + lane * 4;
        f32x4 v = bf4(*(const u32x2*)(Hin + (size_t)row * D + col));
        if (nparts > 0) {
            const bf16_t* pr = (const bf16_t*)(p.ws + WS_PART) + (size_t)tr * 2048 + col;
            u32x2 q[16];
#pragma unroll
            for (int sp = 0; sp < 16; ++sp) q[sp] = (sp < nparts) ? *(const u32x2*)(pr + (size_t)sp * (512 * 2048)) : (u32x2){0u, 0u};
#pragma unroll
            for (int sp = 0; sp < 16; ++sp) v += bf4(q[sp]);
            { u32x2 w; w.x = pk2(v.x, v.y); w.y = pk2(v.z, v.w); *(u32x2*)((bf16_t*)(p.ws + h_out) + (size_t)row * D + col) = w; }
        }
        const float s = wave_sum((v.x * v.x + v.y * v.y) + (v.z * v.z + v.w * v.w), lane);
        if (lane == 0) red[wave] = s;
        __syncthreads();
        float tot = 0.f;
#pragma unroll
        for (int w = 0; w < 8; ++w) tot += red[w];
        norm_out(p, final_, row, col, v, 1.f / sqrtf(tot * (1.f / D) + EPS));
        __syncthreads();
    }
    for (int row = gw; row < MAIN; row += 2 * NGW) {
        const int row1 = row + NGW; const bool has1 = row1 < MAIN;
        const u32x2* h0 = (const u32x2*)(H + (size_t)row * D) + lane; const u32x2* h1 = (const u32x2*)(H + (size_t)(has1 ? row1 : row) * D) + lane;
        f32x4 v0[8], v1[8]; float s0 = 0.f, s1 = 0.f;
        u32x2 w0[8], w1[8];
#pragma unroll
        for (int j = 0; j < 8; ++j) { w0[j] = h0[64 * j]; w1[j] = h1[64 * j]; }
#pragma unroll
        for (int j = 0; j < 8; ++j) { v0[j] = bf4(w0[j]); v1[j] = bf4(w1[j]); }
#pragma unroll
        for (int j = 0; j < 8; ++j) { s0 += (v0[j].x * v0[j].x + v0[j].y * v0[j].y) + (v0[j].z * v0[j].z + v0[j].w * v0[j].w); s1 += (v1[j].x * v1[j].x + v1[j].y * v1[j].y) + (v1[j].z * v1[j].z + v1[j].w * v1[j].w); }
        const float r0 = 1.f / sqrtf(wave_sum(s0, lane) * (1.f / D) + EPS), r1 = 1.f / sqrtf(wave_sum(s1, lane) * (1.f / D) + EPS);
#pragma unroll
        for (int j = 0; j < 8; ++j) norm_out(p, final_, row, j * 256 + lane * 4, v0[j], r0);
        if (has1) {
#pragma unroll
            for (int j = 0; j < 8; ++j) norm_out(p, final_, row1, j * 256 + lane * 4, v1[j], r1); }
    }
}

__device__ __forceinline__ float sigmoidf_(float x) { return __builtin_amdgcn_rcpf(1.f + __expf(-x)); }
__device__ __forceinline__ float gelu_tanh(float x) { const float u = 0.7978845608028654f * (x + 0.044715f * x * x * x); return x * __builtin_amdgcn_rcpf(1.f + __expf(-2.f * u)); }

constexpr int KS_STRIDE = 272;
constexpr int KS_ROWS = 272;
constexpr int VT_STRIDE = 568;
constexpr int KS_OFF = 0, VT_OFF = KS_ROWS * KS_STRIDE  , BIAS_OFF = VT_OFF + 128 * VT_STRIDE  ;
static_assert(BIAS_OFF + 4 * 128 * 4 <= LDS_BYTES, "lds");

__device__ __forceinline__ void attn_item(PRM& p, int l, int it, LAS unsigned char* lds) {
    const int tid = otid(), lane = tid & 63, wave = __builtin_amdgcn_readfirstlane(tid >> 6), fr = lane & 15, fq = lane >> 4;
    const bf16_t* Z = (const bf16_t*)(p.ws + WS_Z);
    bf16_t* ATT = (bf16_t*)(p.ws + WS_ATT);
    const bool samp = it >= NB * 17 * 2;
    int b = 0, qt = 0, g = 0, db = 0;
    if (!samp) { b = it / 34; qt = (it % 34) >> 1; g = it & 1; } else { const int j = it - NB * 17 * 2; db = j >> 1; g = j & 1; }
    int niter, tile0, dbase, kvmin = 0;
    if (!samp) { niter = (128 * qt + 16 * wave < TP) ? 4 : 0; tile0 = wave; dbase = 128 + 16 * wave; kvmin = (qt == 0) ? 128 : 0; }
    else { niter = wave < 4 ? 1 : 0; tile0 = 0; dbase = 128; }
    int qrow; bool qvalid;
    if (!samp) { const int t = 128 * qt + 16 * wave + fr; qvalid = t < TP; qrow = b * TP + (qvalid ? t : TP - 1); }
    else { qvalid = fr < DSEQ; qrow = MP + db * DSEQ + (qvalid ? fr : 0); }
    bf16x8 qf[4][4];
#pragma unroll
    for (int itr = 0; itr < 4; ++itr) { const int hh = samp ? wave & 3 : itr; const bf16_t* qp = Z + (size_t)qrow * INW + ZQ + (g * 4 + hh) * 128 + fq * 8;
#pragma unroll
        for (int ks = 0; ks < 4; ++ks) qf[itr][ks] = (itr < niter) ? *(const bf16x8*)(qp + ks * 32) : (bf16x8){0, 0, 0, 0, 0, 0, 0, 0}; }
    constexpr int NCH = KS_ROWS * 16;
    if (!samp) {
        u32x4 kq[9], vq[9];
#pragma unroll
        for (int q = 0; q < 9; ++q) { const int i = tid + q * NTHREADS, idx = i >> 4, c8 = i & 15, pos = 128 * qt - 128 + idx;
            kq[q] = (u32x4){0u, 0u, 0u, 0u}; vq[q] = kq[q];
            if (i < NCH && pos >= 0 && pos < TP) { const bf16_t* zr = Z + (size_t)(b * TP + pos) * INW + g * 128 + c8 * 8; kq[q] = *(const u32x4*)(zr + ZK); vq[q] = *(const u32x4*)(zr + ZV); } }
#pragma unroll
        for (int q = 0; q < 9; ++q) { const int i = tid + q * NTHREADS, idx = i >> 4, c8 = i & 15;
            if (i < NCH) { *(LAS u32x4*)(lds + KS_OFF + idx * KS_STRIDE + c8 * 16) = kq[q];
                LAS bf16_t* vt = (LAS bf16_t*)(lds + VT_OFF) + (c8 * 8) * (VT_STRIDE / 2) + idx;
#pragma unroll
                for (int e = 0; e < 4; ++e) { vt[(2 * e) * (VT_STRIDE / 2)] = (bf16_t)(vq[q][e] & 0xffffu); vt[(2 * e + 1) * (VT_STRIDE / 2)] = (bf16_t)(vq[q][e] >> 16); } } }
    } else {
#pragma unroll 2
        for (int i = tid; i < 160 * 16; i += NTHREADS) { const int idx = i >> 4, c8 = i & 15;
            u32x4 kq = (u32x4){0u, 0u, 0u, 0u}, vq = kq;
            if (idx < 128) { const size_t o = (((size_t)l * DBAT + db) * 128 + idx) * 256 + g * 128 + c8 * 8;
                const f32x4 k0 = *(const f32x4*)(p.in[2] + o), k1 = *(const f32x4*)(p.in[2] + o + 4), v0 = *(const f32x4*)(p.in[3] + o), v1 = *(const f32x4*)(p.in[3] + o + 4);
                kq.x = pk2(k0.x, k0.y); kq.y = pk2(k0.z, k0.w); kq.z = pk2(k1.x, k1.y); kq.w = pk2(k1.z, k1.w);
                vq.x = pk2(v0.x, v0.y); vq.y = pk2(v0.z, v0.w); vq.z = pk2(v1.x, v1.y); vq.w = pk2(v1.z, v1.w); }
            else if (idx < 128 + DSEQ) { const bf16_t* zr = Z + (size_t)(MP + db * DSEQ + idx - 128) * INW + g * 128 + c8 * 8; kq = *(const u32x4*)(zr + ZK); vq = *(const u32x4*)(zr + ZV); }
            *(LAS u32x4*)(lds + KS_OFF + idx * KS_STRIDE + c8 * 16) = kq;
            LAS bf16_t* vt = (LAS bf16_t*)(lds + VT_OFF) + (c8 * 8) * (VT_STRIDE / 2) + idx;
#pragma unroll
            for (int e = 0; e < 4; ++e) { vt[(2 * e) * (VT_STRIDE / 2)] = (bf16_t)(vq[e] & 0xffffu); vt[(2 * e + 1) * (VT_STRIDE / 2)] = (bf16_t)(vq[e] >> 16); } }
    }
    {
        const int hh = tid >> 7, dist = tid & 127;
        int bucket = dist;
        if (dist >= 16) {
            bucket = 16 + (dist >= 19) + (dist >= 21) + (dist >= 24) + (dist >= 27) + (dist >= 31) + (dist >= 35) + (dist >= 40) + (dist >= 46) + (dist >= 52) + (dist >= 59)
                   + (dist >= 67) + (dist >= 77) + (dist >= 87) + (dist >= 99) + (dist >= 113); }
        ((LAS float*)(lds + BIAS_OFF))[tid] = p.in[17][bucket * 8 + g * 4 + hh] * 1.4426950408889634f;
    }
    __syncthreads();
    const int npair = niter == 0 ? 0 : (samp ? 1 : 2);
#pragma unroll
    for (int hp = 0; hp < 2; ++hp) {
        if (hp >= npair) break;
        const int hh0 = samp ? wave : 2 * hp, hh1 = samp ? wave : 2 * hp + 1;
        f32x4 s[2][10];
        const LAS float* bias0 = (const LAS float*)(lds + BIAS_OFF) + hh0 * 128; const LAS float* bias1 = (const LAS float*)(lds + BIAS_OFF) + hh1 * 128;
        const float sc = 0.08838834764831845f * 1.4426950408889634f;
        float mx0 = -1e30f, mx1 = -1e30f;
#pragma unroll
        for (int kt = 0; kt < 10; ++kt) {
            const int ib = 16 * (tile0 + kt);
            if (kt == 9) { s[0][9] = (f32x4){-1e30f, -1e30f, -1e30f, -1e30f}; s[1][9] = s[0][9]; break; }
            f32x4 a0 = (f32x4){0.f, 0.f, 0.f, 0.f}, a1 = a0;
            const LAS unsigned char* kr = lds + KS_OFF + (ib + fr) * KS_STRIDE + fq * 16;
#pragma unroll
            for (int ks = 0; ks < 4; ++ks) { const bf16x8 kf = *(const LAS bf16x8*)(kr + ks * 64);
                a0 = __builtin_amdgcn_mfma_f32_16x16x32_bf16(kf, qf[2 * hp][ks], a0, 0, 0, 0);
                if (!samp) a1 = __builtin_amdgcn_mfma_f32_16x16x32_bf16(kf, qf[2 * hp + 1][ks], a1, 0, 0, 0); }
            if (!samp && kvmin == 0 && kt >= 1 && kt <= 7) {
#pragma unroll
                for (int j = 0; j < 4; ++j) { const int dist = dbase + fr - (ib + fq * 4 + j);
                    a0[j] = a0[j] * sc + bias0[dist]; mx0 = fmaxf(mx0, a0[j]); a1[j] = a1[j] * sc + bias1[dist]; mx1 = fmaxf(mx1, a1[j]); }
            } else {
#pragma unroll
                for (int j = 0; j < 4; ++j) { const int idx = ib + fq * 4 + j, dist = dbase + fr - idx;
                    const bool ok = (idx >= kvmin) && (dist >= 0) && (dist < 128);
                    const int di = ok ? dist : 0;
                    a0[j] = ok ? a0[j] * sc + bias0[di] : -1e30f; mx0 = fmaxf(mx0, a0[j]);
                    a1[j] = ok ? a1[j] * sc + bias1[di] : -1e30f; mx1 = fmaxf(mx1, a1[j]); }
            }
            s[0][kt] = a0; s[1][kt] = a1;
            __builtin_amdgcn_sched_barrier(0);
        }
        mx0 = fmaxf(mx0, shx(mx0, lane, 16)); mx0 = fmaxf(mx0, shx(mx0, lane, 32));
        mx1 = fmaxf(mx1, shx(mx1, lane, 16)); mx1 = fmaxf(mx1, shx(mx1, lane, 32));
        const float sink0 = p.in[16][l * 8 + g * 4 + hh0] * 1.4426950408889634f, sink1 = p.in[16][l * 8 + g * 4 + hh1] * 1.4426950408889634f;
        mx0 = fmaxf(mx0, sink0); mx1 = fmaxf(mx1, sink1);
        float sum0 = 0.f, sum1 = 0.f;
#pragma unroll
        for (int kt = 0; kt < 10; ++kt)
#pragma unroll
            for (int j = 0; j < 4; ++j) { const float e0 = __builtin_amdgcn_exp2f(s[0][kt][j] - mx0); s[0][kt][j] = e0; sum0 += e0; const float e1 = __builtin_amdgcn_exp2f(s[1][kt][j] - mx1); s[1][kt][j] = e1; sum1 += e1; }
        sum0 += shx(sum0, lane, 16); sum0 += shx(sum0, lane, 32); sum1 += shx(sum1, lane, 16); sum1 += shx(sum1, lane, 32);
        const float inv0 = 1.f / (sum0 + __builtin_amdgcn_exp2f(sink0 - mx0)), inv1 = 1.f / (sum1 + __builtin_amdgcn_exp2f(sink1 - mx1));
        f32x4 o0[8], o1[8];
#pragma unroll
        for (int dt = 0; dt < 8; ++dt) { o0[dt] = (f32x4){0.f, 0.f, 0.f, 0.f}; o1[dt] = o0[dt]; }
#pragma unroll
        for (int pp = 0; pp < 5; ++pp) {
            u32x4 w; w.x = pk2(s[0][2 * pp][0], s[0][2 * pp][1]); w.y = pk2(s[0][2 * pp][2], s[0][2 * pp][3]); w.z = pk2(s[0][2 * pp + 1][0], s[0][2 * pp + 1][1]); w.w = pk2(s[0][2 * pp + 1][2], s[0][2 * pp + 1][3]);
            const bf16x8 pf0 = __builtin_bit_cast(bf16x8, w);
            w.x = pk2(s[1][2 * pp][0], s[1][2 * pp][1]); w.y = pk2(s[1][2 * pp][2], s[1][2 * pp][3]); w.z = pk2(s[1][2 * pp + 1][0], s[1][2 * pp + 1][1]); w.w = pk2(s[1][2 * pp + 1][2], s[1][2 * pp + 1][3]);
            const bf16x8 pf1 = __builtin_bit_cast(bf16x8, w);
            const int ib = 16 * (tile0 + 2 * pp);
#pragma unroll
            for (int dt = 0; dt < 8; ++dt) {
                const LAS unsigned char* vr = lds + VT_OFF + (dt * 16 + fr) * VT_STRIDE + (ib + fq * 4) * 2;
                u32x4 vw; const u32x2 v0 = *(const LAS u32x2*)vr, v1 = *(const LAS u32x2*)(vr + 32); vw.x = v0.x; vw.y = v0.y; vw.z = v1.x; vw.w = v1.y;
                o0[dt] = __builtin_amdgcn_mfma_f32_16x16x32_bf16(__builtin_bit_cast(bf16x8, vw), pf0, o0[dt], 0, 0, 0);
                if (!samp) o1[dt] = __builtin_amdgcn_mfma_f32_16x16x32_bf16(__builtin_bit_cast(bf16x8, vw), pf1, o1[dt], 0, 0, 0);
            }
            __builtin_amdgcn_sched_barrier(0);
        }
        if (qvalid) { bf16_t* op = ATT + (size_t)qrow * ATTW + (g * 4 + hh0) * 128 + fq * 4;
#pragma unroll
            for (int dt = 0; dt < 8; ++dt) { u32x2 w; w.x = pk2(o0[dt][0] * inv0, o0[dt][1] * inv0); w.y = pk2(o0[dt][2] * inv0, o0[dt][3] * inv0); *(u32x2*)(op + dt * 16) = w; }
            if (!samp) { bf16_t* op1 = ATT + (size_t)qrow * ATTW + (g * 4 + hh1) * 128 + fq * 4;
#pragma unroll
                for (int dt = 0; dt < 8; ++dt) { u32x2 w; w.x = pk2(o1[dt][0] * inv1, o1[dt][1] * inv1); w.y = pk2(o1[dt][2] * inv1, o1[dt][3] * inv1); *(u32x2*)(op1 + dt * 16) = w; } } }
    }
}

constexpr int XC_OFF = 0, XCB_OFF = 64 * 128 * 4  , XCB_STRIDE = 272, LA_OFF = XCB_OFF + 64 * XCB_STRIDE  , GX_OFF = LA_OFF + 64 * 128 * 4  ;
static_assert(GX_OFF + 64 * 128 * 4 <= LDS_BYTES, "lds");

struct RecIn { bf16x8 bfr[2][4]; float gbias[2], gsp, cw[4], cb, w0, w1, w2, xs[16], sc0[3], sc1[3]; };
struct RecIdx { bool samp; int b, c, blk, sg, nrows, R0, t0; };
__device__ __forceinline__ RecIdx rec_idx(int it) {
    RecIdx x; x.samp = it >= NB * 33 * 8; x.b = 0; x.c = 0; x.sg = 0; x.t0 = 0;
    if (!x.samp) { x.b = it / 264; x.c = (it % 264) >> 3; x.blk = it & 7; x.t0 = 64 * x.c; x.nrows = (TP - x.t0) < 64 ? (TP - x.t0) : 64; x.R0 = x.b * TP + x.t0; }
    else { const int j = it - NB * 33 * 8; x.sg = j >> 3; x.blk = j & 7; x.nrows = 64; x.R0 = MP + x.sg * 64; }
    return x;
}
__device__ __forceinline__ void rec_load(PRM& p, int l, int it, RecIn& in) {
    const int tid = otid(), lane = tid & 63, wave = __builtin_amdgcn_readfirstlane(tid >> 6), fr = lane & 15, fq = lane >> 4;
    const bf16_t* Z = (const bf16_t*)(p.ws + WS_Z);
    const RecIdx x = rec_idx(it);
    const int ch = tid & 127, sub = tid >> 7, chg = x.blk * 128 + ch;
    { const int ccg = x.blk * 128 + wave * 16 + fr;
#pragma unroll
      for (int gt_ = 0; gt_ < 2; ++gt_) { const bf16_t* wg = (const bf16_t*)(p.ws + WS_WG) + (((size_t)l * 2 + gt_) * 8 + x.blk) * 16384;
#pragma unroll
          for (int ks = 0; ks < 4; ++ks) in.bfr[gt_][ks] = *(const bf16x8*)(wg + (size_t)(wave * 16 + fr) * 128 + ks * 32 + fq * 8);
          in.gbias[gt_] = (gt_ ? p.in[14] : p.in[12])[l * LRUW + ccg]; }
      in.gsp = p.in[15][l * LRUW + ccg]; }
#pragma unroll
    for (int q = 0; q < 4; ++q) in.cw[q] = p.in[9][(l * 4 + q) * LRUW + chg];
    in.cb = p.in[10][l * LRUW + chg];
    in.w0 = 0.f; in.w1 = 0.f; in.w2 = 0.f;
#pragma unroll
    for (int q = 0; q < 3; ++q) { in.sc0[q] = 0.f; in.sc1[q] = 0.f; }
#pragma unroll
    for (int rr = 0; rr < 16; ++rr) in.xs[rr] = 0.f;
    if (sub * 16 < x.nrows) {
        if (!x.samp) { const int t = x.t0 + sub * 16; const bf16_t* zc = Z + (size_t)(x.b * TP) * INW + ZX + chg;
            if (t - 3 >= 0) in.w0 = bf2f(zc[(size_t)(t - 3) * INW]); if (t - 2 >= 0) in.w1 = bf2f(zc[(size_t)(t - 2) * INW]); if (t - 1 >= 0) in.w2 = bf2f(zc[(size_t)(t - 1) * INW]); }
#pragma unroll
        for (int rr = 0; rr < 16; ++rr) in.xs[rr] = bf2f(Z[(size_t)(x.R0 + sub * 16 + rr) * INW + ZX + chg]);
        if (x.samp) { const float* s0 = p.in[4] + ((size_t)l * DBAT + x.sg * 8 + sub * 2) * 3 * LRUW + chg;
#pragma unroll
            for (int q = 0; q < 3; ++q) { in.sc0[q] = s0[q * LRUW]; in.sc1[q] = s0[(3 + q) * LRUW]; } }
    }
}
__device__ __forceinline__ void rec_item(PRM& p, int l, int it, const RecIn& in, LAS unsigned char* lds) {
    const int tid = otid(), lane = tid & 63, wave = __builtin_amdgcn_readfirstlane(tid >> 6), fr = lane & 15, fq = lane >> 4;
    const RecIdx x = rec_idx(it);
    const bool samp = x.samp; const int b = x.b, c = x.c, blk = x.blk, sg = x.sg, nrows = x.nrows, R0 = x.R0, t0 = x.t0;
    LAS float* xc_s = (LAS float*)(lds + XC_OFF);
    const int ch = tid & 127, sub = tid >> 7, chg = blk * 128 + ch;
    const float gbias[2] = {in.gbias[0], in.gbias[1]};
    const float gsp = (-in.gsp > 20.f) ? -in.gsp : log1pf(__expf(-in.gsp));
    const float k_a = -8.f * gsp * 1.4426950408889634f, k_x2 = -16.f * gsp;
    if (sub * 16 < nrows) {
        float w0 = in.w0, w1 = in.w1, w2 = in.w2;
#pragma unroll
        for (int rr = 0; rr < 16; ++rr) {
            const int r = sub * 16 + rr;
            if (samp && rr == 0) { w0 = in.sc0[0]; w1 = in.sc0[1]; w2 = in.sc0[2]; }
            if (samp && rr == 8) { w0 = in.sc1[0]; w1 = in.sc1[1]; w2 = in.sc1[2]; }
            const float xv = in.xs[rr];
            const float xc = in.cb + w0 * in.cw[0] + w1 * in.cw[1] + w2 * in.cw[2] + xv * in.cw[3];
            xc_s[r * 128 + ch] = xc;
            *(LAS bf16_t*)(lds + XCB_OFF + r * XCB_STRIDE + ch * 2) = (bf16_t)f2bf_hw(xc);
            w0 = w1; w1 = w2; w2 = xv;
        }
        if (!samp) { if (t0 + sub * 16 + 16 == TP) {
#pragma unroll
            for (int q = 0; q < 3; ++q) p.out[O_CP + (((size_t)l * NB + b) * 3 + q) * LRUW + chg] = in.xs[13 + q]; } }
        else {
#pragma unroll
            for (int q = 0; q < 3; ++q) { p.out[O_CS + (((size_t)l * DBAT + sg * 8 + sub * 2) * 3 + q) * LRUW + chg] = in.xs[5 + q];
                p.out[O_CS + (((size_t)l * DBAT + sg * 8 + sub * 2 + 1) * 3 + q) * LRUW + chg] = in.xs[13 + q]; } }
    }
    __syncthreads();
    {
        unsigned* HA = (unsigned*)(p.ws + WS_HLOC);
        const int cc = wave * 16 + fr, ccg = blk * 128 + cc;
        const int nmt = nrows >> 4;
        float c64A = 1.f, c64H = 0.f;
        const bool first_tok = !samp && t0 == 0;
        for (int mt = 0; mt < nmt; ++mt) {
            f32x4 acc[2] = {(f32x4){0.f, 0.f, 0.f, 0.f}, (f32x4){0.f, 0.f, 0.f, 0.f}};
#pragma unroll
            for (int ks = 0; ks < 4; ++ks) { const bf16x8 af = *(const LAS bf16x8*)(lds + XCB_OFF + (mt * 16 + fr) * XCB_STRIDE + ks * 64 + fq * 16);
#pragma unroll
                for (int gt_ = 0; gt_ < 2; ++gt_) acc[gt_] = __builtin_amdgcn_mfma_f32_16x16x32_bf16(af, in.bfr[gt_][ks], acc[gt_], 0, 0, 0); }
            float aj[4], hj[4];
            float A = 1.f, h = 0.f;
#pragma unroll
            for (int j = 0; j < 4; ++j) { const int r = mt * 16 + fq * 4 + j;
                const float ga_ = sigmoidf_(acc[0][j] + gbias[0]), a = __builtin_amdgcn_exp2f(ga_ * k_a), gx = sigmoidf_(acc[1][j] + gbias[1]);
                const float x2 = ga_ * k_x2;
                const float em = (x2 > -0.1f) ? -x2 * (1.f + x2 * (0.5f + x2 * 0.16666667f)) : 1.f - a * a;
                float mult = __builtin_amdgcn_sqrtf(em);
                if (j == 0 && first_tok && mt == 0 && fq == 0) mult = 1.f;
                const float bt = xc_s[r * 128 + cc] * gx * mult;
                if (samp && (j == 0) && ((fq & 1) == 0)) { A = 1.f; h = 0.f; }
                h = a * h + bt; A *= a; aj[j] = A; hj[j] = h; }
            float xA = A, xH = h;
            { const int src = (lane - 16) & 63; const float yA = __builtin_bit_cast(float, __builtin_amdgcn_ds_bpermute(src << 2, __builtin_bit_cast(int, xA))), yH = __builtin_bit_cast(float, __builtin_amdgcn_ds_bpermute(src << 2, __builtin_bit_cast(int, xH)));
              const bool ok = samp ? (fq & 1) : (fq >= 1); if (ok) { xH = xA * yH + xH; xA = yA * xA; } }
            { const int src = (lane - 32) & 63; const float yA = __builtin_bit_cast(float, __builtin_amdgcn_ds_bpermute(src << 2, __builtin_bit_cast(int, xA))), yH = __builtin_bit_cast(float, __builtin_amdgcn_ds_bpermute(src << 2, __builtin_bit_cast(int, xH)));
              const bool ok = !samp && (fq >= 2); if (ok) { xH = xA * yH + xH; xA = yA * xA; } }
            float cA = 1.f, cH = 0.f;
            { const int src = (lane - 16) & 63; const float yA = __builtin_bit_cast(float, __builtin_amdgcn_ds_bpermute(src << 2, __builtin_bit_cast(int, xA))), yH = __builtin_bit_cast(float, __builtin_amdgcn_ds_bpermute(src << 2, __builtin_bit_cast(int, xH)));
              const bool ok = samp ? (fq & 1) : (fq >= 1); if (ok) { cA = yA; cH = yH; } }
#pragma unroll
            for (int j = 0; j < 4; ++j) { const int row = R0 + mt * 16 + fq * 4 + j;
                HA[(size_t)row * LRUW + ccg] = pk2(hj[j] + aj[j] * cH, aj[j] * cA); }
            if (!samp && fq == 3) {
                const int grp = (t0 + mt * 16) >> 4;
                ((float*)(p.ws + WS_AGGA))[((size_t)b * NGRP + grp) * LRUW + ccg] = xA; ((float*)(p.ws + WS_AGGH))[((size_t)b * NGRP + grp) * LRUW + ccg] = xH;
                c64H = xA * c64H + xH; c64A *= xA; }
        }
        if (!samp && fq == 3) { ((float*)(p.ws + WS_AG64A))[((size_t)b * 33 + c) * LRUW + ccg] = c64A; ((float*)(p.ws + WS_AG64H))[((size_t)b * 33 + c) * LRUW + ccg] = c64H; }
    }
}

__device__ __forceinline__ void phase_mixA(PRM& p, int l, LAS unsigned char* lds) {
    const int tid = otid();
    const size_t gt = (size_t)blockIdx.x * NTHREADS + tid, GT = (size_t)gridDim.x * NTHREADS;
    const bf16_t* Z = (const bf16_t*)(p.ws + WS_Z);
    for (size_t i = gt; i < (size_t)NB * 128 * 64; i += GT) {
        const int c4 = i & 63, w = (i >> 6) & 127, b = (int)(i >> 13);
        const bf16_t* zr = Z + (size_t)(b * TP + TP - 128 + w) * INW + c4 * 4;
        ((f32x4*)(p.out + O_KP))[((size_t)l * NB * 128 * 64) + i] = bf4(*(const u32x2*)(zr + ZK));
        ((f32x4*)(p.out + O_VP))[((size_t)l * NB * 128 * 64) + i] = bf4(*(const u32x2*)(zr + ZV));
    }
    for (size_t i = gt; i < (size_t)DBAT * 128 * 64; i += GT) {
        const int c4 = i & 63, w = (i >> 6) & 127, db = (int)(i >> 13);
        const int idx = w + DSEQ;
        f32x4 kv, vv;
        if (idx < 128) { const size_t o = (((size_t)l * DBAT + db) * 128 + idx) * 64 + c4; kv = ((const f32x4*)p.in[2])[o]; vv = ((const f32x4*)p.in[3])[o]; }
        else { const bf16_t* zr = Z + (size_t)(MP + db * DSEQ + idx - 128) * INW + c4 * 4; kv = bf4(*(const u32x2*)(zr + ZK)); vv = bf4(*(const u32x2*)(zr + ZV)); }
        ((f32x4*)(p.out + O_KS))[((size_t)l * DBAT * 128 * 64) + i] = kv;
        ((f32x4*)(p.out + O_VS))[((size_t)l * DBAT * 128 * 64) + i] = vv;
    }
    constexpr int NATT = NB * 17 * 2 + DBAT * 2, NREC = NB * 33 * 8 + 4 * 8;
    for (int it = blockIdx.x; it < NATT; it += gridDim.x) { attn_item(p, l, it, lds); __syncthreads(); }
    if (gridDim.x == 256) {
        const int bx = blockIdx.x; int first, cnt;
        if (bx < 136) { first = bx * 3; cnt = 3; } else if (bx < 200) { first = 408 + (bx - 136) * 5; cnt = 5; }
        else if (bx < 232) { first = 728 + (bx - 200) * 6; cnt = 6; } else { first = 920 + (bx - 232) * 7; cnt = 7; }
        RecIn cur, nxt; rec_load(p, l, first, cur);
        for (int k = 0; k < cnt; ++k) {
            if (k + 1 < cnt) rec_load(p, l, first + k + 1, nxt);
            rec_item(p, l, first + k, cur, lds); __syncthreads();
            cur = nxt;
        }
    } else {
        for (int it = blockIdx.x; it < NREC; it += gridDim.x) { RecIn cur; rec_load(p, l, it, cur); rec_item(p, l, it, cur, lds); __syncthreads(); }
    }
}

__device__ __forceinline__ void phase_mixB(PRM& p, int l, LAS unsigned char* lds) {
    const int tid = otid(), lane = tid & 63, wave = tid >> 6;
    LAS float* c_s = (LAS float*)lds;
    const unsigned* HA = (const unsigned*)(p.ws + WS_HLOC);
    bf16_t* MIX = (bf16_t*)(p.ws + WS_MIX);
    constexpr int NIT_P = NB * NGRP, NIT = NIT_P + MS / 16;
    const bool pair = gridDim.x == 256;
    float pc0 = 0.f, pc1 = 0.f; int pb = -1, pgrp = -1;
    for (int rep = 0; ; ++rep) {
        int it;
        if (pair) {
            const int x = blockIdx.x; if (rep > 2) break;
            if (x < 4) it = 3 * x + rep;
            else if (rep < 2) it = 12 + 2 * (x - 4) + rep;
            else { if (x >= 20) break; it = NIT_P + (x - 4); }
        } else it = blockIdx.x + rep * gridDim.x;
        if (it >= NIT) break;
        const bool samp = it >= NIT_P;
        int b = 0, grp = 0, R0;
        if (!samp) { b = it / NGRP; grp = it % NGRP; R0 = b * TP + grp * 16;
            const float* ga = (const float*)(p.ws + WS_AGGA) + (size_t)b * NGRP * LRUW; const float* gh = (const float*)(p.ws + WS_AGGH) + (size_t)b * NGRP * LRUW;
            const float* ca = (const float*)(p.ws + WS_AG64A) + (size_t)b * 33 * LRUW; const float* chh = (const float*)(p.ws + WS_AG64H) + (size_t)b * 33 * LRUW;
            float c0, c1;
            if (b == pb && grp == pgrp + 1) {
                const size_t o = (size_t)pgrp * LRUW + tid; c0 = ga[o] * pc0 + gh[o]; c1 = ga[o + 512] * pc1 + gh[o + 512];
            } else {
                const int n64 = grp >> 2; c0 = 0.f; c1 = 0.f;
#pragma unroll 16
                for (int g2 = 0; g2 < n64; ++g2) { const size_t o = (size_t)g2 * LRUW + tid; c0 = ca[o] * c0 + chh[o]; c1 = ca[o + 512] * c1 + chh[o + 512]; }
                for (int g2 = n64 * 4; g2 < grp; ++g2) { const size_t o = (size_t)g2 * LRUW + tid; c0 = ga[o] * c0 + gh[o]; c1 = ga[o + 512] * c1 + gh[o + 512]; }
            }
            pc0 = c0; pc1 = c1; pb = b; pgrp = grp;
            c_s[tid] = c0; c_s[1024 + tid] = c0; c_s[tid + 512] = c1; c_s[1024 + tid + 512] = c1;
        } else { const int j = it - NIT_P; R0 = MP + j * 16;
#pragma unroll
            for (int k = 0; k < 4; ++k) { const int e = tid + k * 512, half = e >> 10, ch = e & 1023; c_s[e] = p.in[5][((size_t)l * DBAT + j * 2 + half) * LRUW + ch]; } }
        __syncthreads();
        {
            const bf16_t* Zb = (const bf16_t*)(p.ws + WS_Z); const bf16_t* ATb = (const bf16_t*)(p.ws + WS_ATT);
            u32x2 aw[2][4], gw2[2][4]; u32x4 ha[2][4];
#pragma unroll
            for (int q = 0; q < 2; ++q) { const int row = R0 + wave * 2 + q;
#pragma unroll
                for (int j = 0; j < 4; ++j) { const int c0 = j * 256 + lane * 4;
                    aw[q][j] = *(const u32x2*)(ATb + (size_t)row * ATTW + c0); gw2[q][j] = *(const u32x2*)(Zb + (size_t)row * INW + ZG + c0);
                    ha[q][j] = *(const u32x4*)(HA + (size_t)row * LRUW + c0); } }
#pragma unroll
            for (int q = 0; q < 2; ++q) {
                const int r = wave * 2 + q, row = R0 + r;
                const LAS float* cs = c_s + ((samp && r >= 8) ? 1024 : 0);
                bool last; float* lout;
                if (!samp) { last = (grp * 16 + r) == TP - 1; lout = p.out + O_LP + ((size_t)l * NB + b) * LRUW; }
                else { last = (r & 7) == 7; lout = p.out + O_LS + ((size_t)l * DBAT + (row - MP) / 8) * LRUW; }
                f32x4 av[4], rv[4]; float ssa = 0.f, ssr = 0.f;
#pragma unroll
                for (int j = 0; j < 4; ++j) { const int c0 = j * 256 + lane * 4;
                    av[j] = bf4(aw[q][j]); const f32x4 gr = bf4(gw2[q][j]); const u32x4 hw_ = ha[q][j];
                    const f32x4 hlf = (f32x4){bflo(hw_.x), bflo(hw_.y), bflo(hw_.z), bflo(hw_.w)}, acf = (f32x4){bfhi(hw_.x), bfhi(hw_.y), bfhi(hw_.z), bfhi(hw_.w)};
                    f32x4 hh;
#pragma unroll
                    for (int e = 0; e < 4; ++e) { hh[e] = hlf[e] + acf[e] * cs[c0 + e]; rv[j][e] = hh[e] * gelu_tanh(gr[e]); ssa += av[j][e] * av[j][e]; ssr += rv[j][e] * rv[j][e]; }
                    if (last) *(f32x4*)(lout + c0) = hh; }
                const float ra = 1.f / sqrtf(wave_sum(ssa, lane) * (1.f / ATTW) + EPS), rr = 1.f / sqrtf(wave_sum(ssr, lane) * (1.f / LRUW) + EPS);
#pragma unroll
                for (int j = 0; j < 4; ++j) { const int c0 = j * 256 + lane * 4;
                    u32x2 w; w.x = pk2(av[j][0] * ra, av[j][1] * ra); w.y = pk2(av[j][2] * ra, av[j][3] * ra); *(u32x2*)(MIX + (size_t)row * D + c0) = w;
                    w.x = pk2(rv[j][0] * rr, rv[j][1] * rr); w.y = pk2(rv[j][2] * rr, rv[j][3] * rr); *(u32x2*)(MIX + (size_t)row * D + ATTW + c0) = w; }
            }
        }
        __syncthreads();
    }
}

constexpr int NPHASE = 1 + 8 * DEPTH;

__device__ __forceinline__ void run_phase(PRM& p, int ph, LAS unsigned char* lds) {
#ifndef EN_PREP
#define EN_PREP 1
#define EN_NORM 1
#define EN_GEMM 1
#define EN_MIXA 1
#define EN_MIXB 1
#endif
    if (ph == 0) { if (EN_PREP) phase_prep(p, lds); return; }
    const int l = (ph - 1) >> 3, s = (ph - 1) & 7;
    if (s == 0 || s == 3 || s == 5 || s == 6) {
        if (EN_GEMM) {
            pg8::Gemm g; pg8::Epi E; g.M = MPAD; E.R = nullptr;
            if (s == 0)      { g.A = (const bf16_t*)(p.ws + WS_U);   g.Bt = (const bf16_t*)(p.ws + WS_WIN) + (size_t)l * INW * D;  g.N = INW; g.K = D;   E.mode = 3; E.C = p.ws + WS_Z;   E.ldc = INW; }
            else if (s == 3) { g.A = (const bf16_t*)(p.ws + WS_MIX); g.Bt = (const bf16_t*)(p.ws + WS_WOUT) + (size_t)l * D * D;   g.N = D;   g.K = D;   E.mode = 1; E.C = p.ws + WS_H2;  E.R = (const bf16_t*)(p.ws + WS_H);  E.ldc = D; }
            else if (s == 5) { g.A = (const bf16_t*)(p.ws + WS_U);   g.Bt = (const bf16_t*)(p.ws + WS_WUP) + (size_t)l * DFF * D;  g.N = DFF; g.K = D;   E.mode = 2; E.C = p.ws + WS_HID; E.ldc = DFF; }
            else             { g.A = (const bf16_t*)(p.ws + WS_HID); g.Bt = (const bf16_t*)(p.ws + WS_WDN) + (size_t)l * D * DFF;  g.N = D;   g.K = DFF; E.mode = 1; E.C = p.ws + WS_H;   E.R = (const bf16_t*)(p.ws + WS_H2); E.ldc = D; }
            E.part = (float*)(p.ws + WS_PART);
            pg8::TailOrder S; S.init(MPAD, g.N, g.K, gridDim.x, blockIdx.x, E.mode == 1);
            pg8::gemm_phase(lds, g, S, E);
            if (s == 5 && l + 1 < DEPTH && gridDim.x == 256 && blockIdx.x >= 64)
                prep_transposes(p, lds, (l + 1) * PREP_PER_L, (l + 2) * PREP_PER_L, blockIdx.x - 64, 192);
        }
        return;
    }
    if (s == 1) { if (EN_MIXA) phase_mixA(p, l, lds); return; }
    if (s == 2) { if (EN_MIXB) phase_mixB(p, l, lds); return; }
    if (EN_NORM) phase_norm(p, s == 7 && l == DEPTH - 1, (gridDim.x == 256) ? (s == 4 ? 8 : 16) : 0, s == 4 ? WS_H : WS_H2, s == 4 ? WS_H2 : WS_H, lds);
}

#define XB_TMO      128
#define XB_XCNT(j)  (256  + 64 * (j))
#define XB_XSUB(j)  (1280 + 64 * (j))
#define XB_XGEN(j)  (2304 + 64 * (j))
#define XB_TOP      3328
#define XB_TOPGEN   3392
#define XCD_BAR_WORDS 3456
#define XB_SPIN_CAP (1u << 22)
__device__ __forceinline__ unsigned xb_ld(unsigned* p)              { return __hip_atomic_load(p, __ATOMIC_RELAXED, __HIP_MEMORY_SCOPE_AGENT); }
__device__ __forceinline__ unsigned xb_add(unsigned* p, unsigned v) { return __hip_atomic_fetch_add(p, v, __ATOMIC_RELAXED, __HIP_MEMORY_SCOPE_AGENT); }
__device__ __forceinline__ unsigned xb_xcc_id() { return (unsigned)__builtin_amdgcn_s_getreg((3 << 11) | 20) & 0xFu; }
#define XB_SPIN(cond, bar) do { unsigned _sp = 0; while (cond) { __builtin_amdgcn_s_sleep(1); \
    if ((++_sp & 255u) == 0u) { if (xb_ld(&(bar)[XB_TMO])) break; if (_sp > XB_SPIN_CAP) { atomicAdd(&(bar)[XB_TMO], 1u); break; } } } } while (0)
struct XcdBarrier { unsigned* bar; unsigned x; volatile LAS unsigned* st; };
__device__ __forceinline__ XcdBarrier xcd_barrier_post(unsigned* bar, volatile LAS unsigned* st) {
    XcdBarrier b; b.bar = bar; b.x = xb_xcc_id(); b.st = st;
    if (threadIdx.x == 0) (void)xb_add(&bar[XB_XCNT(b.x)], 1u);
    return b;
}
__device__ __forceinline__ void xcd_barrier_complete(unsigned* bar, unsigned x, unsigned& nloc, unsigned& nx) {
    const unsigned G = gridDim.x * gridDim.y * gridDim.z;
    unsigned sum, cnt, mine, sp = 0u;
    for (;;) {
        sum = 0u; cnt = 0u; mine = 0u;
#pragma unroll
        for (unsigned j = 0; j < 16; ++j) { const unsigned c = xb_ld(&bar[XB_XCNT(j)]); sum += c; cnt += (c > 0u) ? 1u : 0u; mine = (j == x) ? c : mine; }
        if (sum == G) break;
        __builtin_amdgcn_s_sleep(1);
        if ((++sp & 255u) == 0u) { if (xb_ld(&bar[XB_TMO])) break; if (sp > XB_SPIN_CAP) { atomicAdd(&bar[XB_TMO], 1u); break; } }
    }
    nloc = mine > 0u ? mine : 1u; nx = cnt > 0u ? cnt : 1u;
}
__device__ __forceinline__ void xcd_barrier(const XcdBarrier& b) {
    asm volatile("s_waitcnt vmcnt(0)" ::: "memory");
    __syncthreads();
    if (otid() == 0) {
        unsigned* bar = b.bar;
        __builtin_amdgcn_s_waitcnt(0);
        unsigned nloc = b.st[0], nx = b.st[1];
        if (nloc == 0u) { xcd_barrier_complete(bar, b.x, nloc, nx); b.st[0] = nloc; b.st[1] = nx; }
        const unsigned old = xb_add(&bar[XB_XSUB(b.x)], 1u);
        const unsigned gen = old / nloc;
        if (old + 1u == (gen + 1u) * nloc) {
            __builtin_amdgcn_fence(__ATOMIC_RELEASE, "agent");
            asm volatile("s_waitcnt vmcnt(0)" ::: "memory");
            const unsigned og = xb_add(&bar[XB_TOP], 1u);
            const unsigned tg = og / nx;
            if (og + 1u == (tg + 1u) * nx) xb_add(&bar[XB_TOPGEN], 1u);
            else XB_SPIN(xb_ld(&bar[XB_TOPGEN]) == tg, bar);
            __builtin_amdgcn_fence(__ATOMIC_ACQUIRE, "agent");
            xb_add(&bar[XB_XGEN(b.x)], 1u);
            asm volatile("s_waitcnt vmcnt(0)" ::: "memory");
        } else {
            XB_SPIN(xb_ld(&bar[XB_XGEN(b.x)]) == gen, bar);
            __builtin_amdgcn_fence(__ATOMIC_ACQUIRE, "agent");
            asm volatile("s_waitcnt vmcnt(0)" ::: "memory");
        }
    }
    __syncthreads();
}

__device__ __forceinline__ void grid_bar(unsigned* ctr, unsigned target) {
    asm volatile("s_waitcnt vmcnt(0) lgkmcnt(0)" ::: "memory");
    __syncthreads();
    if (otid() == 0) {
        __builtin_amdgcn_fence(__ATOMIC_RELEASE, "agent");
        asm volatile("s_waitcnt vmcnt(0)" ::: "memory");
        __hip_atomic_fetch_add(ctr, 1u, __ATOMIC_RELAXED, __HIP_MEMORY_SCOPE_AGENT);
        while (__hip_atomic_load(ctr, __ATOMIC_RELAXED, __HIP_MEMORY_SCOPE_AGENT) < target) __builtin_amdgcn_s_sleep(2);
        __builtin_amdgcn_fence(__ATOMIC_ACQUIRE, "agent");
        asm volatile("s_waitcnt vmcnt(0)" ::: "memory");
    }
    __syncthreads();
}

__global__ void __launch_bounds__(512, 2) hymba_fwd(Params p) {
    extern __shared__ __attribute__((aligned(16))) unsigned char shm[];
    LAS unsigned char* lds = (LAS unsigned char*)shm;
    volatile LAS unsigned* bst = (volatile LAS unsigned*)(lds + LDS_BYTES - 16);
    if (otid() < 2) bst[otid()] = 0u;
    __syncthreads();
    XcdBarrier xbar; xbar.bar = (unsigned*)(p.ws + WS_BAR) + 64; xbar.x = 0; xbar.st = bst;
    if (p.ph_hi - p.ph_lo > 1) {
        xbar = xcd_barrier_post((unsigned*)(p.ws + WS_BAR) + 64, bst);
        if (p.ph_lo < 0) cg::this_grid().sync();
    }
    unsigned nbar = 0;
    for (int ph = p.ph_lo; ph < p.ph_hi; ++ph) {
        PRM* pp = (PRM*)__builtin_amdgcn_kernarg_segment_ptr(); asm volatile("" : "+s"(pp));
        run_phase(*pp, ph, lds);
#if defined(PROBE_REPEAT)
        { const int kind = ph < 1 ? 100 + ph : ((ph - 1) & 7);
          if (kind == PROBE_REPEAT) { ++nbar; grid_bar((unsigned*)(pp->ws + WS_BAR), nbar * gridDim.x); run_phase(*pp, ph, lds); }
          if (PROBE_REPEAT == 200 && ph >= 2) for (int r = 0; r < 4; ++r) { ++nbar; grid_bar((unsigned*)(pp->ws + WS_BAR), nbar * gridDim.x); } }
#endif
        if (ph + 1 < p.ph_hi) xcd_barrier(xbar);
    }
}

extern "C" void kernel_launch(void* const* d_in, const int* in_sizes, int n_in, void* d_out, int out_size, void* d_ws, size_t ws_size, hipStream_t stream) {
    static int grid = 0;
    if (grid == 0) {
        if (n_in != 25 || (size_t)out_size != O_END || ws_size < WS_END) { fprintf(stderr, "kernel_launch: unexpected shapes: n_in %d out %d ws %zu (need %zu)\n", n_in, out_size, ws_size, (size_t)WS_END); grid = -1; return; }
        int dev = 0, cus = 0, per_cu = 0;
        hipGetDevice(&dev); hipDeviceGetAttribute(&cus, hipDeviceAttributeMultiprocessorCount, dev);
        if (hipFuncSetAttribute((const void*)hymba_fwd, hipFuncAttributeMaxDynamicSharedMemorySize, LDS_BYTES) != hipSuccess) { fprintf(stderr, "kernel_launch: hipFuncSetAttribute failed\n"); grid = -1; return; }
        hipOccupancyMaxActiveBlocksPerMultiprocessor(&per_cu, (const void*)hymba_fwd, NTHREADS, LDS_BYTES);
        if (per_cu < 1) { fprintf(stderr, "kernel_launch: occupancy query says %d blocks per CU\n", per_cu); per_cu = 1; }
        (void)hipGetLastError();
        grid = cus * 1;
    }
    if (grid < 0) return;
    Params p{};
    for (int i = 0; i < 25; ++i) p.in[i] = (const float*)d_in[i];
    p.out = (float*)d_out; p.ws = (unsigned char*)d_ws;
#if MK_SINGLE
    hipMemsetAsync((char*)d_ws + WS_BAR, 0, 256 + XCD_BAR_WORDS_C * 4, stream);
    p.ph_lo = 0; p.ph_hi = NPHASE;
    void* args[] = {&p};
    hipError_t e = hipLaunchCooperativeKernel((const void*)hymba_fwd, dim3(grid), dim3(NTHREADS), args, LDS_BYTES, stream);
    if (e != hipSuccess) fprintf(stderr, "cooperative launch failed: %s (grid %d)\n", hipGetErrorString(e), grid);
#else
    for (int ph = 0; ph < NPHASE; ++ph) {
        p.ph_lo = ph; p.ph_hi = ph + 1;
        hipLaunchKernelGGL(hymba_fwd, dim3(grid), dim3(NTHREADS), LDS_BYTES, stream, p);
    }
#endif
}
```

```cpp
#include <hip/hip_runtime.h>
#include <hip/hip_cooperative_groups.h>
#include <cstdio>
#include <cstdint>
namespace cg = cooperative_groups;

#ifndef MK_SINGLE
#define MK_SINGLE 1
#endif

#define LAS __attribute__((address_space(3)))
typedef unsigned short bf16_t;
typedef short bf16x8 __attribute__((ext_vector_type(8)));
typedef short bf16x4 __attribute__((ext_vector_type(4)));
typedef float f32x4 __attribute__((ext_vector_type(4)));
typedef unsigned u32x4 __attribute__((ext_vector_type(4)));
typedef unsigned u32x2 __attribute__((ext_vector_type(2)));

constexpr int D = 2048, NB = 4, SEQ = 2048, NMETA = 16, TP = SEQ + NMETA, DEPTH = 4, DBAT = 32, DSEQ = 8;
constexpr int MP = NB * TP, MS = DBAT * DSEQ, MV = MP + MS, MPAD = 8704;
constexpr int INW = 3584, DFF = 8192, LRUW = 1024, ATTW = 1024, NGRP = TP / 16  ;
constexpr int ZQ = 0, ZK = 1024, ZV = 1280, ZX = 1536, ZG = 2560;
constexpr float EPS = 1e-6f;
constexpr int NTHREADS = 512, NWAVES = 8;
constexpr int LDS_BYTES = 150 * 1024;
constexpr int XCD_BAR_WORDS_C = 3456;

constexpr size_t al256(size_t x) { return (x + 255) & ~(size_t)255; }
constexpr size_t WS_WIN = 0;
constexpr size_t WS_WOUT = WS_WIN + (size_t)DEPTH * INW * D * 2;
constexpr size_t WS_WUP = WS_WOUT + (size_t)DEPTH * D * D * 2;
constexpr size_t WS_WDN = WS_WUP + (size_t)DEPTH * DFF * D * 2;
constexpr size_t WS_WG = WS_WDN + (size_t)DEPTH * D * DFF * 2;
constexpr size_t WS_H = WS_WG + (size_t)DEPTH * 2 * 8 * 128 * 128 * 2;
constexpr size_t WS_U = WS_H + (size_t)MPAD * D * 4;
constexpr size_t WS_Z = WS_U + (size_t)MPAD * D * 2;
constexpr size_t WS_ATT = WS_Z + (size_t)MPAD * INW * 4;
constexpr size_t WS_HLOC = WS_ATT + (size_t)MPAD * ATTW * 4;
constexpr size_t WS_ACUM = WS_HLOC + (size_t)MPAD * LRUW * 4;
constexpr size_t WS_AGGA = WS_ACUM + (size_t)MPAD * LRUW * 4;
constexpr size_t WS_AGGH = WS_AGGA + (size_t)NB * NGRP * LRUW * 4;
constexpr size_t WS_AG64A = WS_AGGH + (size_t)NB * NGRP * LRUW * 4;
constexpr size_t WS_AG64H = WS_AG64A + (size_t)NB * 33 * LRUW * 4;
constexpr size_t WS_MIX = WS_AG64H + (size_t)NB * 33 * LRUW * 4;
constexpr size_t WS_HID = WS_MIX + (size_t)MPAD * D * 2;
constexpr size_t WS_PART = WS_HID + (size_t)MPAD * DFF * 2;
constexpr size_t WS_H2 = WS_PART + (size_t)16 * 512 * 2048 * 4;
constexpr size_t WS_BAR = WS_H2 + (size_t)MPAD * D * 4;
constexpr size_t WS_END = WS_BAR + 256 + XCD_BAR_WORDS_C * 4;

constexpr size_t O_YP = 0;
constexpr size_t O_YS = O_YP + (size_t)NB * SEQ * D;
constexpr size_t O_KP = O_YS + (size_t)MS * D;
constexpr size_t O_VP = O_KP + (size_t)DEPTH * NB * 128 * 256;
constexpr size_t O_CP = O_VP + (size_t)DEPTH * NB * 128 * 256;
constexpr size_t O_LP = O_CP + (size_t)DEPTH * NB * 3 * LRUW;
constexpr size_t O_KS = O_LP + (size_t)DEPTH * NB * LRUW;
constexpr size_t O_VS = O_KS + (size_t)DEPTH * DBAT * 128 * 256;
constexpr size_t O_CS = O_VS + (size_t)DEPTH * DBAT * 128 * 256;
constexpr size_t O_LS = O_CS + (size_t)DEPTH * DBAT * 3 * LRUW;
constexpr size_t O_END = O_LS + (size_t)DEPTH * DBAT * LRUW;

struct Params;
typedef const Params __attribute__((address_space(4))) PRM;
struct Params {
    const float* in[25];
    float* out;
    unsigned char* ws;
    int ph_lo, ph_hi;
};

__device__ __forceinline__ unsigned f2bf(float f) { unsigned u = __builtin_bit_cast(unsigned, f); return (u + 0x7fffu + ((u >> 16) & 1u)) >> 16; }
__device__ __forceinline__ unsigned f2bf_hw(float f) { unsigned r; asm("v_cvt_pk_bf16_f32 %0, %1, %1" : "=v"(r) : "v"(f)); return r & 0xffffu; }
__device__ __forceinline__ unsigned pk2(float lo, float hi) { unsigned r; asm("v_cvt_pk_bf16_f32 %0, %1, %2" : "=v"(r) : "v"(lo), "v"(hi)); return r; }
__device__ __forceinline__ float shx(float v, int lane, int o) { return __builtin_bit_cast(float, __builtin_amdgcn_ds_bpermute((lane ^ o) << 2, __builtin_bit_cast(int, v))); }
__device__ __forceinline__ float wave_sum(float v, int lane) {
#pragma unroll
    for (int o = 1; o < 64; o <<= 1) v += shx(v, lane, o);
    return v;
}
__device__ __forceinline__ int otid() { int t = threadIdx.x; asm volatile("" : "+v"(t)); return t; }
__device__ __forceinline__ float bflo(unsigned w) { return __builtin_bit_cast(float, w << 16); }
__device__ __forceinline__ float bfhi(unsigned w) { return __builtin_bit_cast(float, w & 0xffff0000u); }
__device__ __forceinline__ float bf2f(bf16_t v) { return __builtin_bit_cast(float, (unsigned)v << 16); }
__device__ __forceinline__ f32x4 bf4(u32x2 w) { return (f32x4){bflo(w.x), bfhi(w.x), bflo(w.y), bfhi(w.y)}; }
#define LDS_WAIT() asm volatile("s_waitcnt lgkmcnt(0)" ::: "memory")

namespace pg8 {
constexpr int BM = 256, BK = 64, HALF = 128, HTB = HALF * BK * 2, STAGE_BYTES = 8 * HTB, NXCD = 8, WGM = 8;
__host__ __device__ __forceinline__ int lds_byte(int r, int c) { const int st = (r >> 4) * 2 + (c >> 5), rr = r & 15, cc = c & 31, ob = rr * 64 + cc * 2; return st * 1024 + (ob ^ (((ob >> 9) & 1) << 5)); }
__host__ __device__ __forceinline__ void stage_rc(int b, int& R, int& C) { const int st = b / 1024, sb = b % 1024, swz = sb ^ (((sb >> 9) & 1) << 5); R = (st >> 1) * 16 + swz / 64; C = (st & 1) * 32 + (swz % 64) / 2; }
__host__ __device__ __forceinline__ int perm32(int rho) { const int n = rho >> 4, i = rho & 15; return 8 * (i >> 2) + 4 * n + (i & 3); }

struct Unit { int pm, pn, k0, nkt, part; };
struct Gemm { const bf16_t* A; const bf16_t* Bt; int M, N, K; };

struct StaticOrder {
    int nM, nN, nwg, G, c;
    __host__ __device__ void init(int M, int N, int G_, int c_) { nM = M / BM; nN = N / BM; nwg = nM * nN; G = G_; c = c_; }
    __host__ __device__ bool next(int i, Unit& u) const {
        const long L = (long)i * G + c; if (L >= nwg) return false;
        int wgid = (int)L; { const int q = nwg / NXCD, r = nwg % NXCD, xcd = wgid % NXCD, off = wgid / NXCD; wgid = (xcd < r ? xcd * (q + 1) : r * (q + 1) + (xcd - r) * q) + off; }
        const int nig = WGM * nN, gid = wgid / nig, fm = gid * WGM, gsz = (nM - fm) < WGM ? (nM - fm) : WGM;
        u.pm = fm + ((wgid % nig) % gsz); u.pn = (wgid % nig) / gsz; return true;
    }
};
struct TailOrder {
    StaticOrder so; int nkt, S, c;
    __host__ __device__ void init(int M, int N, int K, int G, int c_, bool split) {
        nkt = K / BK; c = c_; S = 1;
        if (split && M == 34 * BM && N == 8 * BM && G == 256) S = nkt >= 128 ? 16 : 8;
        so.init(S == 1 ? M : 32 * BM, N, G, c_);
    }
    __host__ __device__ bool next(int i, Unit& u) const {
        u.k0 = 0; u.nkt = nkt; u.part = -1;
        if (S == 1 || i == 0) return so.next(i, u);
        if (i != 1 || c >= 16 * S) return false;
        const int x = c & 7, y = c >> 3, r = S >> 3, sp = x + 8 * (y % r), j = y / r;
        u.pm = 32 + (j >> 3); u.pn = j & 7; u.nkt = nkt / S; u.k0 = sp * u.nkt; u.part = sp; return true;
    }
    __device__ __forceinline__ void a_ready(const Unit&) const {}
    __device__ __forceinline__ void done(const Unit&) const {}
};

struct Epi {
    int mode; void* C; int ldc; float* part; const bf16_t* R;
    __device__ __forceinline__ void operator()(const f32x4 (&acc)[2][2][4][2], const Unit& u, int wr, int wc, int fr, int fq) const {
        if (u.part >= 0) {
            const int row0 = (u.pm - 32) * BM + wr * 64 + fr, col0 = u.pn * BM + wc * 32 + 8 * fq;
            bf16_t* P = (bf16_t*)part + (size_t)u.part * (512 * 2048);
#pragma unroll
            for (int ai = 0; ai < 2; ++ai)
#pragma unroll
                for (int m = 0; m < 4; ++m) { bf16_t* rowp = P + (size_t)(row0 + ai * HALF + m * 16) * 2048 + col0;
#pragma unroll
                    for (int bj = 0; bj < 2; ++bj) { const f32x4 v0 = acc[ai][bj][m][0], v1 = acc[ai][bj][m][1];
                        u32x4 o; o.x = pk2(v0[0], v0[1]); o.y = pk2(v0[2], v0[3]); o.z = pk2(v1[0], v1[1]); o.w = pk2(v1[2], v1[3]);
                        *(u32x4*)(rowp + bj * HALF) = o; } }
            return;
        }
        const int row0 = u.pm * BM + wr * 64 + fr;
        if (mode >= 1) {
            const bool act = mode == 2;
            const int col0 = u.pn * BM + wc * 32 + 8 * fq;
#pragma unroll
            for (int ai = 0; ai < 2; ++ai)
#pragma unroll
                for (int m = 0; m < 4; ++m) { bf16_t* rowp = (bf16_t*)C + (size_t)(row0 + ai * HALF + m * 16) * ldc + col0;
#pragma unroll
                    for (int bj = 0; bj < 2; ++bj) { f32x4 v0 = acc[ai][bj][m][0], v1 = acc[ai][bj][m][1];
                        if (mode == 1) { const u32x4 rr = *(const u32x4*)(R + (size_t)(row0 + ai * HALF + m * 16) * ldc + col0 + bj * HALF);
                            v0 += (f32x4){bflo(rr.x), bfhi(rr.x), bflo(rr.y), bfhi(rr.y)}; v1 += (f32x4){bflo(rr.z), bfhi(rr.z), bflo(rr.w), bfhi(rr.w)}; }
#pragma unroll
                        for (int e = 0; e < 4; ++e) { float a = fmaxf(v0[e], 0.f), b = fmaxf(v1[e], 0.f); v0[e] = act ? a * a : v0[e]; v1[e] = act ? b * b : v1[e]; }
                        u32x4 o; o.x = pk2(v0[0], v0[1]); o.y = pk2(v0[2], v0[3]); o.z = pk2(v1[0], v1[1]); o.w = pk2(v1[2], v1[3]);
                        *(u32x4*)(rowp + bj * HALF) = o; } }
        } else {
            const int col0 = u.pn * BM + wc * 32 + 4 * fq;
            const bool add = mode == 1;
#pragma unroll
            for (int ai = 0; ai < 2; ++ai)
#pragma unroll
                for (int m = 0; m < 4; ++m) { float* rowp = (float*)C + (size_t)(row0 + ai * HALF + m * 16) * ldc + col0;
                    f32x4 old[2][2];
#pragma unroll
                    for (int bj = 0; bj < 2; ++bj)
#pragma unroll
                        for (int n = 0; n < 2; ++n) old[bj][n] = add ? *(const f32x4*)(R + (size_t)(row0 + ai * HALF + m * 16) * ldc + col0 + bj * HALF + n * 16) : (f32x4){0.f, 0.f, 0.f, 0.f};
#pragma unroll
                    for (int bj = 0; bj < 2; ++bj)
#pragma unroll
                        for (int n = 0; n < 2; ++n) *(f32x4*)(rowp + bj * HALF + n * 16) = acc[ai][bj][m][n] + old[bj][n]; }
        }
    }
};

template <class Sched>
__device__ __forceinline__ void gemm_phase(LAS unsigned char* lds, const Gemm g, const Sched& S, const Epi& E) {
    const int tid = otid(), wid = __builtin_amdgcn_readfirstlane(tid >> 6), lane = tid & 63, wr = wid >> 2, wc = wid & 3, fr = lane & 15, fq = lane >> 4;
    const int K = g.K;
    unsigned voffA[2], voffB[2];
#pragma unroll
    for (int i = 0; i < 2; ++i) { int R, C; stage_rc(tid * 16 + i * 8192, R, C); const int Rb = (E.mode >= 1) ? ((R & ~31) + perm32(R & 31)) : R;
        voffA[i] = (unsigned)(R * K + C) * 2u; voffB[i] = (unsigned)(Rb * K + C) * 2u; }
    const size_t kstep = (size_t)(BK * 2);
    const size_t hstep = (size_t)HALF * K * 2;
    const size_t tstep = 2 * hstep;
    const unsigned ldsw = (unsigned)wid * 1024u;
    const int aoff = lds_byte(wr * 64 + fr, fq * 8), boff = lds_byte(wc * 32 + fr, fq * 8);
#define PG8_SA(b, h) (((b) * 2 + (h)) * HTB)
#define PG8_SB(b, h) ((4 + (b) * 2 + (h)) * HTB)
#define PG8_STAGE(bufoff, gbase, voff) do { _Pragma("unroll") for (int _i = 0; _i < 2; ++_i) \
        __builtin_amdgcn_global_load_lds((const unsigned*)((const char*)(gbase) + (voff)[_i]), (LAS unsigned*)(lds + (bufoff) + ldsw + _i * 8192), 16, 0, 0); } while (0)
#define PG8_LDA(dst, b, h) do { _Pragma("unroll") for (int m = 0; m < 4; ++m) _Pragma("unroll") for (int k = 0; k < 2; ++k) dst[m][k] = *(const LAS bf16x8*)(lds + PG8_SA(b, h) + aoff + m * 2048 + k * 1024); } while (0)
#define PG8_LDB(dst, b, h) do { _Pragma("unroll") for (int n = 0; n < 2; ++n) _Pragma("unroll") for (int k = 0; k < 2; ++k) dst[n][k] = *(const LAS bf16x8*)(lds + PG8_SB(b, h) + boff + n * 2048 + k * 1024); } while (0)
#define PG8_MMA(ai, bj, At, Bt) do { __builtin_amdgcn_s_setprio(1); _Pragma("unroll") for (int m = 0; m < 4; ++m) _Pragma("unroll") for (int n = 0; n < 2; ++n) _Pragma("unroll") for (int k = 0; k < 2; ++k) \
        acc[ai][bj][m][n] = __builtin_amdgcn_mfma_f32_16x16x32_bf16(Bt[n][k], At[m][k], acc[ai][bj][m][n], 0, 0, 0); __builtin_amdgcn_s_setprio(0); } while (0)
#define PG8_WAIT_V(n) asm volatile("s_waitcnt vmcnt(" #n ")" ::: "memory")
#define PG8_WAIT_L(n) asm volatile("s_waitcnt lgkmcnt(" #n ")" ::: "memory")
#define PG8_BAR __builtin_amdgcn_s_barrier()
#define PG8_SCHED __builtin_amdgcn_sched_barrier(0)
    Unit cur, nxt; int ui = 0;
    if (!S.next(0, cur)) return;
    f32x4 acc[2][2][4][2];
#pragma unroll
    for (int a = 0; a < 2; ++a)
#pragma unroll
        for (int b = 0; b < 2; ++b)
#pragma unroll
            for (int m = 0; m < 4; ++m)
#pragma unroll
                for (int n = 0; n < 2; ++n) acc[a][b][m][n] = (f32x4){0.f, 0.f, 0.f, 0.f};
    bf16x8 At[4][2], B0[2][2], B1[2][2];
    const char* cA = (const char*)g.A + (size_t)cur.pm * tstep + (size_t)cur.k0 * kstep; const char* cB = (const char*)g.Bt + (size_t)cur.pn * tstep + (size_t)cur.k0 * kstep;
    S.a_ready(cur);
    PG8_STAGE(PG8_SB(0, 0), cB, voffB); PG8_STAGE(PG8_SB(0, 1), cB + hstep, voffB); PG8_STAGE(PG8_SA(0, 0), cA, voffA); PG8_STAGE(PG8_SA(0, 1), cA + hstep, voffA);
    if (wr == 1) PG8_BAR;
    PG8_WAIT_V(2); PG8_BAR;
    PG8_STAGE(PG8_SB(1, 0), cB + kstep, voffB); PG8_STAGE(PG8_SA(1, 0), cA + kstep, voffA); PG8_STAGE(PG8_SB(1, 1), cB + hstep + kstep, voffB);
    PG8_WAIT_V(6); PG8_BAR;
    for (;;) {
        const bool has_next = S.next(ui + 1, nxt);
        const char* nA = has_next ? (const char*)g.A + (size_t)nxt.pm * tstep + (size_t)nxt.k0 * kstep : cA; const char* nB = has_next ? (const char*)g.Bt + (size_t)nxt.pn * tstep + (size_t)nxt.k0 * kstep : cB;
        const int nt = cur.nkt;
        for (int t = 0; t < nt; t += 2) {
            const bool last = (t == nt - 2);
            const char* a1 = cA + (size_t)(t + 1) * kstep;
            const char* a2 = last ? nA : cA + (size_t)(t + 2) * kstep; const char* b2 = last ? nB : cB + (size_t)(t + 2) * kstep;
            const char* a3 = a2 + kstep; const char* b3 = b2 + kstep;
            if (last && has_next) S.a_ready(nxt);
            PG8_LDB(B0, 0, 0); PG8_LDB(B1, 0, 1); PG8_SCHED; PG8_LDA(At, 0, 0); PG8_STAGE(PG8_SA(1, 1), a1 + hstep, voffA);
            PG8_WAIT_V(8); PG8_WAIT_L(0); PG8_BAR; PG8_MMA(0, 0, At, B0); PG8_MMA(0, 1, At, B1); PG8_BAR; PG8_SCHED;
            PG8_LDA(At, 0, 1); PG8_STAGE(PG8_SB(0, 0), b2, voffB); PG8_STAGE(PG8_SB(0, 1), b2 + hstep, voffB); PG8_STAGE(PG8_SA(0, 0), a2, voffA);
            PG8_WAIT_V(8); PG8_WAIT_L(0); PG8_BAR; PG8_MMA(1, 0, At, B0); PG8_MMA(1, 1, At, B1); PG8_BAR; PG8_SCHED;
            PG8_LDB(B0, 1, 0); PG8_LDB(B1, 1, 1); PG8_SCHED; PG8_LDA(At, 1, 0); PG8_STAGE(PG8_SA(0, 1), a2 + hstep, voffA);
            PG8_WAIT_V(8); PG8_WAIT_L(0); PG8_BAR; PG8_MMA(0, 0, At, B0); PG8_MMA(0, 1, At, B1); PG8_BAR; PG8_SCHED;
            PG8_LDA(At, 1, 1); PG8_STAGE(PG8_SB(1, 0), b3, voffB); PG8_STAGE(PG8_SB(1, 1), b3 + hstep, voffB); PG8_STAGE(PG8_SA(1, 0), a3, voffA);
            PG8_WAIT_V(8); PG8_WAIT_L(0); PG8_BAR; PG8_MMA(1, 0, At, B0); PG8_MMA(1, 1, At, B1); PG8_BAR; PG8_SCHED;
        }
        if (wr == 0) PG8_BAR;
        E(acc, cur, wr, wc, fr, fq); S.done(cur);
        if (!has_next) break;
#pragma unroll
        for (int a = 0; a < 2; ++a)
#pragma unroll
            for (int b = 0; b < 2; ++b)
#pragma unroll
                for (int m = 0; m < 4; ++m)
#pragma unroll
                    for (int n = 0; n < 2; ++n) acc[a][b][m][n] = (f32x4){0.f, 0.f, 0.f, 0.f};
        cur = nxt; cA = nA; cB = nB; ++ui;
        if (wr == 1) PG8_BAR;
    }
    PG8_WAIT_V(0);
    PG8_BAR;
#undef PG8_SA
#undef PG8_SB
#undef PG8_STAGE
#undef PG8_LDA
#undef PG8_LDB
#undef PG8_MMA
#undef PG8_WAIT_V
#undef PG8_WAIT_L
#undef PG8_BAR
#undef PG8_SCHED
}
}

struct TItem { const float* W; const float* g0; const float* g1; bf16_t* WT; int K, N, k0, n0; };
__device__ __forceinline__ TItem prep_item(PRM& p, int it) {
    constexpr int I_IN = (D / 64) * (INW / 256), I_OUT = (D / 64) * (D / 256), I_UP = (D / 64) * (DFF / 256), I_DN = (DFF / 64) * (D / 256);
    constexpr int PER_L = I_IN + I_OUT + I_UP + I_DN;
    const int l = it / PER_L; int r = it % PER_L; TItem t;
    if (r < I_IN) { t.W = p.in[8] + (size_t)l * D * INW; t.g0 = p.in[7] + l * D; t.g1 = nullptr; t.WT = (bf16_t*)(p.ws + WS_WIN) + (size_t)l * INW * D; t.K = D; t.N = INW; }
    else if ((r -= I_IN) < I_OUT) { t.W = p.in[20] + (size_t)l * D * D; t.g0 = p.in[18] + l * ATTW; t.g1 = p.in[19] + l * LRUW; t.WT = (bf16_t*)(p.ws + WS_WOUT) + (size_t)l * D * D; t.K = D; t.N = D; }
    else if ((r -= I_OUT) < I_UP) { t.W = p.in[22] + (size_t)l * D * DFF; t.g0 = p.in[21] + l * D; t.g1 = nullptr; t.WT = (bf16_t*)(p.ws + WS_WUP) + (size_t)l * DFF * D; t.K = D; t.N = DFF; }
    else { r -= I_UP; t.W = p.in[23] + (size_t)l * DFF * D; t.g0 = nullptr; t.g1 = nullptr; t.WT = (bf16_t*)(p.ws + WS_WDN) + (size_t)l * D * DFF; t.K = DFF; t.N = D; }
    const int nblk = t.N / 256; t.k0 = 64 * (r / nblk); t.n0 = 256 * (r % nblk);
    return t;
}
__device__ __forceinline__ void prep_load(const TItem& t, int wave, int lane, f32x4 (&v)[8]) {
#pragma unroll
    for (int r = 0; r < 8; ++r) { const int k = t.k0 + 8 * wave + r; v[r] = *(const f32x4*)(t.W + (size_t)k * t.N + t.n0 + 4 * lane); }
}
constexpr int PREP_ITEMS = DEPTH * ((D / 64) * (INW / 256) + (D / 64) * (D / 256) + (D / 64) * (DFF / 256) + (DFF / 64) * (D / 256));

__device__ __forceinline__ void prep_transposes(PRM& p, LAS unsigned char* lds, int it0, int it1, int w, int nw) {
    const int tid = otid(), lane = tid & 63, wave = tid >> 6;
    LAS float* tile = (LAS float*)lds;
    int it = it0 + w;
    f32x4 v[8];
    TItem cur = prep_item(p, it < it1 ? it : it0);
    if (it < it1) prep_load(cur, wave, lane, v);
    for (; it < it1; it += nw) {
#pragma unroll
        for (int r = 0; r < 8; ++r) { const int kk = 8 * wave + r, k = cur.k0 + kk;
            float sc = 1.f; if (cur.g0) sc = (cur.g1 && k >= 1024) ? cur.g1[k - 1024] : cur.g0[k];
            *(LAS f32x4*)(tile + kk * 260 + 4 * lane) = v[r] * sc; }
        __syncthreads();
        const TItem me = cur;
        const int nit = it + nw;
        if (nit < it1) { cur = prep_item(p, nit); prep_load(cur, wave, lane, v); }
#pragma unroll
        for (int j = 0; j < 4; ++j) { const int pair = j * 512 + tid, n = pair >> 3, c = pair & 7; const LAS float* sp = tile + (8 * c) * 260 + n;
            u32x4 o; o.x = pk2(sp[0 * 260], sp[1 * 260]); o.y = pk2(sp[2 * 260], sp[3 * 260]); o.z = pk2(sp[4 * 260], sp[5 * 260]); o.w = pk2(sp[6 * 260], sp[7 * 260]);
            *(u32x4*)(me.WT + (size_t)(me.n0 + n) * me.K + me.k0 + 8 * c) = o; }
        __syncthreads();
    }
}
constexpr int PREP_PER_L = PREP_ITEMS / DEPTH;
__device__ __forceinline__ void phase_prep(PRM& p, LAS unsigned char* lds) {
    const int tid = otid(), lane = tid & 63, wave = tid >> 6;
    prep_transposes(p, lds, 0, gridDim.x == 256 ? (D / 64) * (INW / 256) + (D / 64) * (D / 256) + (D / 64) * (DFF / 256) : PREP_ITEMS, blockIdx.x, gridDim.x);
    const size_t gt = (size_t)blockIdx.x * NTHREADS + tid, GT = (size_t)gridDim.x * NTHREADS;
    {
        LAS float* tl = (LAS float*)lds;
        bf16_t* wg = (bf16_t*)(p.ws + WS_WG);
        for (int m = blockIdx.x; m < DEPTH * 2 * 8; m += gridDim.x) {
            const int blk = m & 7, gate = (m >> 3) & 1, l = m >> 4;
            const f32x4* src = (const f32x4*)((gate ? p.in[13] : p.in[11]) + ((size_t)l * 8 + blk) * 16384);
            __syncthreads();
#pragma unroll
            for (int k = 0; k < 8; ++k) { const int i4 = tid + k * NTHREADS, c = i4 >> 5, d = (i4 & 31) * 4; const f32x4 v = src[i4];
                tl[c * 129 + d] = v.x; tl[c * 129 + d + 1] = v.y; tl[c * 129 + d + 2] = v.z; tl[c * 129 + d + 3] = v.w; }
            __syncthreads();
            unsigned* dst = (unsigned*)(wg + (size_t)m * 16384);
#pragma unroll
            for (int k = 0; k < 16; ++k) { const int o = tid + k * NTHREADS, d = o >> 6, c2 = (o & 63) * 2; dst[o] = pk2(tl[c2 * 129 + d], tl[(c2 + 1) * 129 + d]); }
        }
        __syncthreads();
    }
    {
        const int gw = blockIdx.x * NWAVES + wave, NGW = gridDim.x * NWAVES;
        for (int row = gw; row < MPAD; row += NGW) {
            const float* src = nullptr;
            if (row < MP) { const int b = row / TP, t = row % TP; src = t < NMETA ? p.in[6] + (size_t)t * D : p.in[0] + ((size_t)b * SEQ + (t - NMETA)) * D; }
            else if (row < MV) src = p.in[1] + (size_t)(row - MP) * D;
            f32x4 v[8]; float sq = 0.f;
#pragma unroll
            for (int j = 0; j < 8; ++j) { v[j] = src ? *(const f32x4*)(src + j * 256 + lane * 4) : (f32x4){0.f, 0.f, 0.f, 0.f}; sq += (v[j].x * v[j].x + v[j].y * v[j].y) + (v[j].z * v[j].z + v[j].w * v[j].w); }
#pragma unroll
            for (int j = 0; j < 8; ++j) { u32x2 w; w.x = pk2(v[j].x, v[j].y); w.y = pk2(v[j].z, v[j].w); *(u32x2*)((bf16_t*)(p.ws + WS_H) + (size_t)row * D + j * 256 + lane * 4) = w; }
            if (row < MV) { const float rs = 1.f / sqrtf(wave_sum(sq, lane) * (1.f / D) + EPS);
#pragma unroll
                for (int j = 0; j < 8; ++j) { u32x2 w; w.x = pk2(v[j].x * rs, v[j].y * rs); w.y = pk2(v[j].z * rs, v[j].w * rs); *(u32x2*)((bf16_t*)(p.ws + WS_U) + (size_t)row * D + j * 256 + lane * 4) = w; } }
        }
    }
    { u32x4 z4 = (u32x4){0u, 0u, 0u, 0u};
      u32x4* u4 = (u32x4*)(p.ws + WS_U) + (size_t)MV * (D / 8); for (size_t i = gt; i < (size_t)(MPAD - MV) * (D / 8); i += GT) u4[i] = z4;
      u32x4* m4 = (u32x4*)(p.ws + WS_MIX) + (size_t)MV * (D / 8); for (size_t i = gt; i < (size_t)(MPAD - MV) * (D / 8); i += GT) m4[i] = z4;
      u32x4* d4 = (u32x4*)(p.ws + WS_HID) + (size_t)MV * (DFF / 8); for (size_t i = gt; i < (size_t)(MPAD - MV) * (DFF / 8); i += GT) d4[i] = z4; }
}

__device__ __forceinline__ void norm_out(PRM& p, bool final_, int row, int col, f32x4 v, float rstd) {
    if (!final_) { u32x2 w; w.x = pk2(v.x * rstd, v.y * rstd); w.y = pk2(v.z * rstd, v.w * rstd); *(u32x2*)((bf16_t*)(p.ws + WS_U) + (size_t)row * D + col) = w; }
    else { float* dst = nullptr;
        if (row < MP) { const int b = row / TP, t = row % TP; if (t >= NMETA) dst = p.out + O_YP + ((size_t)b * SEQ + (t - NMETA)) * D; }
        else dst = p.out + O_YS + (size_t)(row - MP) * D;
        if (dst) { const f32x4 g = *(const f32x4*)(p.in[24] + col); *(f32x4*)(dst + col) = v * rstd * g; } }
}
__device__ __forceinline__ void phase_norm(PRM& p, bool final_, int nparts, size_t h_in, size_t h_out, LAS unsigned char* lds) {
    const int tid = otid(), lane = tid & 63, wave = tid >> 6;
    const int gw = blockIdx.x * NWAVES + wave, NGW = gridDim.x * NWAVES;
    const bf16_t* H = (const bf16_t*)(p.ws + h_out); const bf16_t* Hin = (const bf16_t*)(p.ws + (nparts > 0 ? h_in : h_out));
    constexpr int MAIN = 32 * 256;
    LAS float* red = (LAS float*)lds;
    for (int tr = blockIdx.x; tr < MV - MAIN; tr += gridDim.x) {
        const int row = MAIN + tr, col = wave * 256 + lane * 4;
        f32x4 v = bf4(*(const u32x2*)(Hin + (size_t)row * D + col));
        if (nparts > 0) {
            const bf16_t* pr = (const bf16_t*)(p.ws + WS_PART) + (size_t)tr * 2048 + col;
            u32x2 q[16];
#pragma unroll
            for (int sp = 0; sp < 16; ++sp) q[sp] = (sp < nparts) ? *(const u32x2*)(pr + (size_t)sp * (512 * 2048)) : (u32x2){0u, 0u};
#pragma unroll
            for (int sp = 0; sp < 16; ++sp) v += bf4(q[sp]);
            { u32x2 w; w.x = pk2(v.x, v.y); w.y = pk2(v.z, v.w); *(u32x2*)((bf16_t*)(p.ws + h_out) + (size_t)row * D + col) = w; }
        }
        const float s = wave_sum((v.x * v.x + v.y * v.y) + (v.z * v.z + v.w * v.w), lane);
        if (lane == 0) red[wave] = s;
        __syncthreads();
        float tot = 0.f;
#pragma unroll
        for (int w = 0; w < 8; ++w) tot += red[w];
        norm_out(p, final_, row, col, v, 1.f / sqrtf(tot * (1.f / D) + EPS));
        __syncthreads();
    }
    for (int row = gw; row < MAIN; row += 2 * NGW) {
        const int row1 = row + NGW; const bool has1 = row1 < MAIN;
        const u32x2* h0 = (const u32x2*)(H + (size_t)row * D) + lane; const u32x2* h1 = (const u32x2*)(H + (size_t)(has1 ? row1 : row) * D) + lane;
        f32x4 v0[8], v1[8]; float s0 = 0.f, s1 = 0.f;
        u32x2 w0[8], w1[8];
#pragma unroll
        for (int j = 0; j < 8; ++j) { w0[j] = h0[64 * j]; w1[j] = h1[64 * j]; }
#pragma unroll
        for (int j = 0; j < 8; ++j) { v0[j] = bf4(w0[j]); v1[j] = bf4(w1[j]); }
#pragma unroll
        for (int j = 0; j < 8; ++j) { s0 += (v0[j].x * v0[j].x + v0[j].y * v0[j].y) + (v0[j].z * v0[j].z + v0[j].w * v0[j].w); s1 += (v1[j].x * v1[j].x + v1[j].y * v1[j].y) + (v1[j].z * v1[j].z + v1[j].w * v1[j].w); }
        const float r0 = 1.f / sqrtf(wave_sum(s0, lane) * (1.f / D) + EPS), r1 = 1.f / sqrtf(wave_sum(s1, lane) * (1.f / D) + EPS);
#pragma unroll
        for (int j = 0; j < 8; ++j) norm_out(p, final_, row, j * 256 + lane * 4, v0[j], r0);
        if (has1) {
#pragma unroll
            for (int j = 0; j < 8; ++j) norm_out(p, final_, row1, j * 256 + lane * 4, v1[j], r1); }
    }
}

__device__ __forceinline__ float sigmoidf_(float x) { return __builtin_amdgcn_rcpf(1.f + __expf(-x)); }
__device__ __forceinline__ float gelu_tanh(float x) { const float u = 0.7978845608028654f * (x + 0.044715f * x * x * x); return x * __builtin_amdgcn_rcpf(1.f + __expf(-2.f * u)); }

constexpr int KS_STRIDE = 272;
constexpr int KS_ROWS = 272;
constexpr int VT_STRIDE = 568;
constexpr int KS_OFF = 0, VT_OFF = KS_ROWS * KS_STRIDE  , BIAS_OFF = VT_OFF + 128 * VT_STRIDE  ;
static_assert(BIAS_OFF + 4 * 128 * 4 <= LDS_BYTES, "lds");

__device__ __forceinline__ void attn_item(PRM& p, int l, int it, LAS unsigned char* lds) {
    const int tid = otid(), lane = tid & 63, wave = __builtin_amdgcn_readfirstlane(tid >> 6), fr = lane & 15, fq = lane >> 4;
    const bf16_t* Z = (const bf16_t*)(p.ws + WS_Z);
    bf16_t* ATT = (bf16_t*)(p.ws + WS_ATT);
    const bool samp = it >= NB * 17 * 2;
    int b = 0, qt = 0, g = 0, db = 0;
    if (!samp) { b = it / 34; qt = (it % 34) >> 1; g = it & 1; } else { const int j = it - NB * 17 * 2; db = j >> 1; g = j & 1; }
    int niter, tile0, dbase, kvmin = 0;
    if (!samp) { niter = (128 * qt + 16 * wave < TP) ? 4 : 0; tile0 = wave; dbase = 128 + 16 * wave; kvmin = (qt == 0) ? 128 : 0; }
    else { niter = wave < 4 ? 1 : 0; tile0 = 0; dbase = 128; }
    int qrow; bool qvalid;
    if (!samp) { const int t = 128 * qt + 16 * wave + fr; qvalid = t < TP; qrow = b * TP + (qvalid ? t : TP - 1); }
    else { qvalid = fr < DSEQ; qrow = MP + db * DSEQ + (qvalid ? fr : 0); }
    bf16x8 qf[4][4];
#pragma unroll
    for (int itr = 0; itr < 4; ++itr) { const int hh = samp ? wave & 3 : itr; const bf16_t* qp = Z + (size_t)qrow * INW + ZQ + (g * 4 + hh) * 128 + fq * 8;
#pragma unroll
        for (int ks = 0; ks < 4; ++ks) qf[itr][ks] = (itr < niter) ? *(const bf16x8*)(qp + ks * 32) : (bf16x8){0, 0, 0, 0, 0, 0, 0, 0}; }
    constexpr int NCH = KS_ROWS * 16;
    if (!samp) {
        u32x4 kq[9], vq[9];
#pragma unroll
        for (int q = 0; q < 9; ++q) { const int i = tid + q * NTHREADS, idx = i >> 4, c8 = i & 15, pos = 128 * qt - 128 + idx;
            kq[q] = (u32x4){0u, 0u, 0u, 0u}; vq[q] = kq[q];
            if (i < NCH && pos >= 0 && pos < TP) { const bf16_t* zr = Z + (size_t)(b * TP + pos) * INW + g * 128 + c8 * 8; kq[q] = *(const u32x4*)(zr + ZK); vq[q] = *(const u32x4*)(zr + ZV); } }
#pragma unroll
        for (int q = 0; q < 9; ++q) { const int i = tid + q * NTHREADS, idx = i >> 4, c8 = i & 15;
            if (i < NCH) { *(LAS u32x4*)(lds + KS_OFF + idx * KS_STRIDE + c8 * 16) = kq[q];
                LAS bf16_t* vt = (LAS bf16_t*)(lds + VT_OFF) + (c8 * 8) * (VT_STRIDE / 2) + idx;
#pragma unroll
                for (int e = 0; e < 4; ++e) { vt[(2 * e) * (VT_STRIDE / 2)] = (bf16_t)(vq[q][e] & 0xffffu); vt[(2 * e + 1) * (VT_STRIDE / 2)] = (bf16_t)(vq[q][e] >> 16); } } }
    } else {
#pragma unroll 2
        for (int i = tid; i < 160 * 16; i += NTHREADS) { const int idx = i >> 4, c8 = i & 15;
            u32x4 kq = (u32x4){0u, 0u, 0u, 0u}, vq = kq;
            if (idx < 128) { const size_t o = (((size_t)l * DBAT + db) * 128 + idx) * 256 + g * 128 + c8 * 8;
                const f32x4 k0 = *(const f32x4*)(p.in[2] + o), k1 = *(const f32x4*)(p.in[2] + o + 4), v0 = *(const f32x4*)(p.in[3] + o), v1 = *(const f32x4*)(p.in[3] + o + 4);
                kq.x = pk2(k0.x, k0.y); kq.y = pk2(k0.z, k0.w); kq.z = pk2(k1.x, k1.y); kq.w = pk2(k1.z, k1.w);
                vq.x = pk2(v0.x, v0.y); vq.y = pk2(v0.z, v0.w); vq.z = pk2(v1.x, v1.y); vq.w = pk2(v1.z, v1.w); }
            else if (idx < 128 + DSEQ) { const bf16_t* zr = Z + (size_t)(MP + db * DSEQ + idx - 128) * INW + g * 128 + c8 * 8; kq = *(const u32x4*)(zr + ZK); vq = *(const u32x4*)(zr + ZV); }
            *(LAS u32x4*)(lds + KS_OFF + idx * KS_STRIDE + c8 * 16) = kq;
            LAS bf16_t* vt = (LAS bf16_t*)(lds + VT_OFF) + (c8 * 8) * (VT_STRIDE / 2) + idx;
#pragma unroll
            for (int e = 0; e < 4; ++e) { vt[(2 * e) * (VT_STRIDE / 2)] = (bf16_t)(vq[e] & 0xffffu); vt[(2 * e + 1) * (VT_STRIDE / 2)] = (bf16_t)(vq[e] >> 16); } }
    }
    {
        const int hh = tid >> 7, dist = tid & 127;
        int bucket = dist;
        if (dist >= 16) {
            bucket = 16 + (dist >= 19) + (dist >= 21) + (dist >= 24) + (dist >= 27) + (dist >= 31) + (dist >= 35) + (dist >= 40) + (dist >= 46) + (dist >= 52) + (dist >= 59)
                   + (dist >= 67) + (dist >= 77) + (dist >= 87) + (dist >= 99) + (dist >= 113); }
        ((LAS float*)(lds + BIAS_OFF))[tid] = p.in[17][bucket * 8 + g * 4 + hh] * 1.4426950408889634f;
    }
    __syncthreads();
    const int npair = niter == 0 ? 0 : (samp ? 1 : 2);
#pragma unroll
    for (int hp = 0; hp < 2; ++hp) {
        if (hp >= npair) break;
        const int hh0 = samp ? wave : 2 * hp, hh1 = samp ? wave : 2 * hp + 1;
        f32x4 s[2][10];
        const LAS float* bias0 = (const LAS float*)(lds + BIAS_OFF) + hh0 * 128; const LAS float* bias1 = (const LAS float*)(lds + BIAS_OFF) + hh1 * 128;
        const float sc = 0.08838834764831845f * 1.4426950408889634f;
        float mx0 = -1e30f, mx1 = -1e30f;
#pragma unroll
        for (int kt = 0; kt < 10; ++kt) {
            const int ib = 16 * (tile0 + kt);
            if (kt == 9) { s[0][9] = (f32x4){-1e30f, -1e30f, -1e30f, -1e30f}; s[1][9] = s[0][9]; break; }
            f32x4 a0 = (f32x4){0.f, 0.f, 0.f, 0.f}, a1 = a0;
            const LAS unsigned char* kr = lds + KS_OFF + (ib + fr) * KS_STRIDE + fq * 16;
#pragma unroll
            for (int ks = 0; ks < 4; ++ks) { const bf16x8 kf = *(const LAS bf16x8*)(kr + ks * 64);
                a0 = __builtin_amdgcn_mfma_f32_16x16x32_bf16(kf, qf[2 * hp][ks], a0, 0, 0, 0);
                if (!samp) a1 = __builtin_amdgcn_mfma_f32_16x16x32_bf16(kf, qf[2 * hp + 1][ks], a1, 0, 0, 0); }
            if (!samp && kvmin == 0 && kt >= 1 && kt <= 7) {
#pragma unroll
                for (int j = 0; j < 4; ++j) { const int dist = dbase + fr - (ib + fq * 4 + j);
                    a0[j] = a0[j] * sc + bias0[dist]; mx0 = fmaxf(mx0, a0[j]); a1[j] = a1[j] * sc + bias1[dist]; mx1 = fmaxf(mx1, a1[j]); }
            } else {
#pragma unroll
                for (int j = 0; j < 4; ++j) { const int idx = ib + fq * 4 + j, dist = dbase + fr - idx;
                    const bool ok = (idx >= kvmin) && (dist >= 0) && (dist < 128);
                    const int di = ok ? dist : 0;
                    a0[j] = ok ? a0[j] * sc + bias0[di] : -1e30f; mx0 = fmaxf(mx0, a0[j]);
                    a1[j] = ok ? a1[j] * sc + bias1[di] : -1e30f; mx1 = fmaxf(mx1, a1[j]); }
            }
            s[0][kt] = a0; s[1][kt] = a1;
            __builtin_amdgcn_sched_barrier(0);
        }
        mx0 = fmaxf(mx0, shx(mx0, lane, 16)); mx0 = fmaxf(mx0, shx(mx0, lane, 32));
        mx1 = fmaxf(mx1, shx(mx1, lane, 16)); mx1 = fmaxf(mx1, shx(mx1, lane, 32));
        const float sink0 = p.in[16][l * 8 + g * 4 + hh0] * 1.4426950408889634f, sink1 = p.in[16][l * 8 + g * 4 + hh1] * 1.4426950408889634f;
        mx0 = fmaxf(mx0, sink0); mx1 = fmaxf(mx1, sink1);
        float sum0 = 0.f, sum1 = 0.f;
#pragma unroll
        for (int kt = 0; kt < 10; ++kt)
#pragma unroll
            for (int j = 0; j < 4; ++j) { const float e0 = __builtin_amdgcn_exp2f(s[0][kt][j] - mx0); s[0][kt][j] = e0; sum0 += e0; const float e1 = __builtin_amdgcn_exp2f(s[1][kt][j] - mx1); s[1][kt][j] = e1; sum1 += e1; }
        sum0 += shx(sum0, lane, 16); sum0 += shx(sum0, lane, 32); sum1 += shx(sum1, lane, 16); sum1 += shx(sum1, lane, 32);
        const float inv0 = 1.f / (sum0 + __builtin_amdgcn_exp2f(sink0 - mx0)), inv1 = 1.f / (sum1 + __builtin_amdgcn_exp2f(sink1 - mx1));
        f32x4 o0[8], o1[8];
#pragma unroll
        for (int dt = 0; dt < 8; ++dt) { o0[dt] = (f32x4){0.f, 0.f, 0.f, 0.f}; o1[dt] = o0[dt]; }
#pragma unroll
        for (int pp = 0; pp < 5; ++pp) {
            u32x4 w; w.x = pk2(s[0][2 * pp][0], s[0][2 * pp][1]); w.y = pk2(s[0][2 * pp][2], s[0][2 * pp][3]); w.z = pk2(s[0][2 * pp + 1][0], s[0][2 * pp + 1][1]); w.w = pk2(s[0][2 * pp + 1][2], s[0][2 * pp + 1][3]);
            const bf16x8 pf0 = __builtin_bit_cast(bf16x8, w);
            w.x = pk2(s[1][2 * pp][0], s[1][2 * pp][1]); w.y = pk2(s[1][2 * pp][2], s[1][2 * pp][3]); w.z = pk2(s[1][2 * pp + 1][0], s[1][2 * pp + 1][1]); w.w = pk2(s[1][2 * pp + 1][2], s[1][2 * pp + 1][3]);
            const bf16x8 pf1 = __builtin_bit_cast(bf16x8, w);
            const int ib = 16 * (tile0 + 2 * pp);
#pragma unroll
            for (int dt = 0; dt < 8; ++dt) {
                const LAS unsigned char* vr = lds + VT_OFF + (dt * 16 + fr) * VT_STRIDE + (ib + fq * 4) * 2;
                u32x4 vw; const u32x2 v0 = *(const LAS u32x2*)vr, v1 = *(const LAS u32x2*)(vr + 32); vw.x = v0.x; vw.y = v0.y; vw.z = v1.x; vw.w = v1.y;
                o0[dt] = __builtin_amdgcn_mfma_f32_16x16x32_bf16(__builtin_bit_cast(bf16x8, vw), pf0, o0[dt], 0, 0, 0);
                if (!samp) o1[dt] = __builtin_amdgcn_mfma_f32_16x16x32_bf16(__builtin_bit_cast(bf16x8, vw), pf1, o1[dt], 0, 0, 0);
            }
            __builtin_amdgcn_sched_barrier(0);
        }
        if (qvalid) { bf16_t* op = ATT + (size_t)qrow * ATTW + (g * 4 + hh0) * 128 + fq * 4;
#pragma unroll
            for (int dt = 0; dt < 8; ++dt) { u32x2 w; w.x = pk2(o0[dt][0] * inv0, o0[dt][1] * inv0); w.y = pk2(o0[dt][2] * inv0, o0[dt][3] * inv0); *(u32x2*)(op + dt * 16) = w; }
            if (!samp) { bf16_t* op1 = ATT + (size_t)qrow * ATTW + (g * 4 + hh1) * 128 + fq * 4;
#pragma unroll
                for (int dt = 0; dt < 8; ++dt) { u32x2 w; w.x = pk2(o1[dt][0] * inv1, o1[dt][1] * inv1); w.y = pk2(o1[dt][2] * inv1, o1[dt][3] * inv1); *(u32x2*)(op1 + dt * 16) = w; } } }
    }
}

constexpr int XC_OFF = 0, XCB_OFF = 64 * 128 * 4  , XCB_STRIDE = 272, LA_OFF = XCB_OFF + 64 * XCB_STRIDE  , GX_OFF = LA_OFF + 64 * 128 * 4  ;
static_assert(GX_OFF + 64 * 128 * 4 <= LDS_BYTES, "lds");

struct RecIn { bf16x8 bfr[2][4]; float gbias[2], gsp, cw[4], cb, w0, w1, w2, xs[16], sc0[3], sc1[3]; };
struct RecIdx { bool samp; int b, c, blk, sg, nrows, R0, t0; };
__device__ __forceinline__ RecIdx rec_idx(int it) {
    RecIdx x; x.samp = it >= NB * 33 * 8; x.b = 0; x.c = 0; x.sg = 0; x.t0 = 0;
    if (!x.samp) { x.b = it / 264; x.c = (it % 264) >> 3; x.blk = it & 7; x.t0 = 64 * x.c; x.nrows = (TP - x.t0) < 64 ? (TP - x.t0) : 64; x.R0 = x.b * TP + x.t0; }
    else { const int j = it - NB * 33 * 8; x.sg = j >> 3; x.blk = j & 7; x.nrows = 64; x.R0 = MP + x.sg * 64; }
    return x;
}
__device__ __forceinline__ void rec_load(PRM& p, int l, int it, RecIn& in) {
    const int tid = otid(), lane = tid & 63, wave = __builtin_amdgcn_readfirstlane(tid >> 6), fr = lane & 15, fq = lane >> 4;
    const bf16_t* Z = (const bf16_t*)(p.ws + WS_Z);
    const RecIdx x = rec_idx(it);
    const int ch = tid & 127, sub = tid >> 7, chg = x.blk * 128 + ch;
    { const int ccg = x.blk * 128 + wave * 16 + fr;
#pragma unroll
      for (int gt_ = 0; gt_ < 2; ++gt_) { const bf16_t* wg = (const bf16_t*)(p.ws + WS_WG) + (((size_t)l * 2 + gt_) * 8 + x.blk) * 16384;
#pragma unroll
          for (int ks = 0; ks < 4; ++ks) in.bfr[gt_][ks] = *(const bf16x8*)(wg + (size_t)(wave * 16 + fr) * 128 + ks * 32 + fq * 8);
          in.gbias[gt_] = (gt_ ? p.in[14] : p.in[12])[l * LRUW + ccg]; }
      in.gsp = p.in[15][l * LRUW + ccg]; }
#pragma unroll
    for (int q = 0; q < 4; ++q) in.cw[q] = p.in[9][(l * 4 + q) * LRUW + chg];
    in.cb = p.in[10][l * LRUW + chg];
    in.w0 = 0.f; in.w1 = 0.f; in.w2 = 0.f;
#pragma unroll
    for (int q = 0; q < 3; ++q) { in.sc0[q] = 0.f; in.sc1[q] = 0.f; }
#pragma unroll
    for (int rr = 0; rr < 16; ++rr) in.xs[rr] = 0.f;
    if (sub * 16 < x.nrows) {
        if (!x.samp) { const int t = x.t0 + sub * 16; const bf16_t* zc = Z + (size_t)(x.b * TP) * INW + ZX + chg;
            if (t - 3 >= 0) in.w0 = bf2f(zc[(size_t)(t - 3) * INW]); if (t - 2 >= 0) in.w1 = bf2f(zc[(size_t)(t - 2) * INW]); if (t - 1 >= 0) in.w2 = bf2f(zc[(size_t)(t - 1) * INW]); }
#pragma unroll
        for (int rr = 0; rr < 16; ++rr) in.xs[rr] = bf2f(Z[(size_t)(x.R0 + sub * 16 + rr) * INW + ZX + chg]);
        if (x.samp) { const float* s0 = p.in[4] + ((size_t)l * DBAT + x.sg * 8 + sub * 2) * 3 * LRUW + chg;
#pragma unroll
            for (int q = 0; q < 3; ++q) { in.sc0[q] = s0[q * LRUW]; in.sc1[q] = s0[(3 + q) * LRUW]; } }
    }
}
__device__ __forceinline__ void rec_item(PRM& p, int l, int it, const RecIn& in, LAS unsigned char* lds) {
    const int tid = otid(), lane = tid & 63, wave = __builtin_amdgcn_readfirstlane(tid >> 6), fr = lane & 15, fq = lane >> 4;
    const RecIdx x = rec_idx(it);
    const bool samp = x.samp; const int b = x.b, c = x.c, blk = x.blk, sg = x.sg, nrows = x.nrows, R0 = x.R0, t0 = x.t0;
    LAS float* xc_s = (LAS float*)(lds + XC_OFF);
    const int ch = tid & 127, sub = tid >> 7, chg = blk * 128 + ch;
    const float gbias[2] = {in.gbias[0], in.gbias[1]};
    const float gsp = (-in.gsp > 20.f) ? -in.gsp : log1pf(__expf(-in.gsp));
    const float k_a = -8.f * gsp * 1.4426950408889634f, k_x2 = -16.f * gsp;
    if (sub * 16 < nrows) {
        float w0 = in.w0, w1 = in.w1, w2 = in.w2;
#pragma unroll
        for (int rr = 0; rr < 16; ++rr) {
            const int r = sub * 16 + rr;
            if (samp && rr == 0) { w0 = in.sc0[0]; w1 = in.sc0[1]; w2 = in.sc0[2]; }
            if (samp && rr == 8) { w0 = in.sc1[0]; w1 = in.sc1[1]; w2 = in.sc1[2]; }
            const float xv = in.xs[rr];
            const float xc = in.cb + w0 * in.cw[0] + w1 * in.cw[1] + w2 * in.cw[2] + xv * in.cw[3];
            xc_s[r * 128 + ch] = xc;
            *(LAS bf16_t*)(lds + XCB_OFF + r * XCB_STRIDE + ch * 2) = (bf16_t)f2bf_hw(xc);
            w0 = w1; w1 = w2; w2 = xv;
        }
        if (!samp) { if (t0 + sub * 16 + 16 == TP) {
#pragma unroll
            for (int q = 0; q < 3; ++q) p.out[O_CP + (((size_t)l * NB + b) * 3 + q) * LRUW + chg] = in.xs[13 + q]; } }
        else {
#pragma unroll
            for (int q = 0; q < 3; ++q) { p.out[O_CS + (((size_t)l * DBAT + sg * 8 + sub * 2) * 3 + q) * LRUW + chg] = in.xs[5 + q];
                p.out[O_CS + (((size_t)l * DBAT + sg * 8 + sub * 2 + 1) * 3 + q) * LRUW + chg] = in.xs[13 + q]; } }
    }
    __syncthreads();
    {
        unsigned* HA = (unsigned*)(p.ws + WS_HLOC);
        const int cc = wave * 16 + fr, ccg = blk * 128 + cc;
        const int nmt = nrows >> 4;
        float c64A = 1.f, c64H = 0.f;
        const bool first_tok = !samp && t0 == 0;
        for (int mt = 0; mt < nmt; ++mt) {
            f32x4 acc[2] = {(f32x4){0.f, 0.f, 0.f, 0.f}, (f32x4){0.f, 0.f, 0.f, 0.f}};
#pragma unroll
            for (int ks = 0; ks < 4; ++ks) { const bf16x8 af = *(const LAS bf16x8*)(lds + XCB_OFF + (mt * 16 + fr) * XCB_STRIDE + ks * 64 + fq * 16);
#pragma unroll
                for (int gt_ = 0; gt_ < 2; ++gt_) acc[gt_] = __builtin_amdgcn_mfma_f32_16x16x32_bf16(af, in.bfr[gt_][ks], acc[gt_], 0, 0, 0); }
            float aj[4], hj[4];
            float A = 1.f, h = 0.f;
#pragma unroll
            for (int j = 0; j < 4; ++j) { const int r = mt * 16 + fq * 4 + j;
                const float ga_ = sigmoidf_(acc[0][j] + gbias[0]), a = __builtin_amdgcn_exp2f(ga_ * k_a), gx = sigmoidf_(acc[1][j] + gbias[1]);
                const float x2 = ga_ * k_x2;
                const float em = (x2 > -0.1f) ? -x2 * (1.f + x2 * (0.5f + x2 * 0.16666667f)) : 1.f - a * a;
                float mult = __builtin_amdgcn_sqrtf(em);
                if (j == 0 && first_tok && mt == 0 && fq == 0) mult = 1.f;
                const float bt = xc_s[r * 128 + cc] * gx * mult;
                if (samp && (j == 0) && ((fq & 1) == 0)) { A = 1.f; h = 0.f; }
                h = a * h + bt; A *= a; aj[j] = A; hj[j] = h; }
            float xA = A, xH = h;
            { const int src = (lane - 16) & 63; const float yA = __builtin_bit_cast(float, __builtin_amdgcn_ds_bpermute(src << 2, __builtin_bit_cast(int, xA))), yH = __builtin_bit_cast(float, __builtin_amdgcn_ds_bpermute(src << 2, __builtin_bit_cast(int, xH)));
              const bool ok = samp ? (fq & 1) : (fq >= 1); if (ok) { xH = xA * yH + xH; xA = yA * xA; } }
            { const int src = (lane - 32) & 63; const float yA = __builtin_bit_cast(float, __builtin_amdgcn_ds_bpermute(src << 2, __builtin_bit_cast(int, xA))), yH = __builtin_bit_cast(float, __builtin_amdgcn_ds_bpermute(src << 2, __builtin_bit_cast(int, xH)));
              const bool ok = !samp && (fq >= 2); if (ok) { xH = xA * yH + xH; xA = yA * xA; } }
            float cA = 1.f, cH = 0.f;
            { const int src = (lane - 16) & 63; const float yA = __builtin_bit_cast(float, __builtin_amdgcn_ds_bpermute(src << 2, __builtin_bit_cast(int, xA))), yH = __builtin_bit_cast(float, __builtin_amdgcn_ds_bpermute(src << 2, __builtin_bit_cast(int, xH)));
              const bool ok = samp ? (fq & 1) : (fq >= 1); if (ok) { cA = yA; cH = yH; } }
#pragma unroll
            for (int j = 0; j < 4; ++j) { const int row = R0 + mt * 16 + fq * 4 + j;
                HA[(size_t)row * LRUW + ccg] = pk2(hj[j] + aj[j] * cH, aj[j] * cA); }
            if (!samp && fq == 3) {
                const int grp = (t0 + mt * 16) >> 4;
                ((float*)(p.ws + WS_AGGA))[((size_t)b * NGRP + grp) * LRUW + ccg] = xA; ((float*)(p.ws + WS_AGGH))[((size_t)b * NGRP + grp) * LRUW + ccg] = xH;
                c64H = xA * c64H + xH; c64A *= xA; }
        }
        if (!samp && fq == 3) { ((float*)(p.ws + WS_AG64A))[((size_t)b * 33 + c) * LRUW + ccg] = c64A; ((float*)(p.ws + WS_AG64H))[((size_t)b * 33 + c) * LRUW + ccg] = c64H; }
    }
}

__device__ __forceinline__ void phase_mixA(PRM& p, int l, LAS unsigned char* lds) {
    const int tid = otid();
    const size_t gt = (size_t)blockIdx.x * NTHREADS + tid, GT = (size_t)gridDim.x * NTHREADS;
    const bf16_t* Z = (const bf16_t*)(p.ws + WS_Z);
    for (size_t i = gt; i < (size_t)NB * 128 * 64; i += GT) {
        const int c4 = i & 63, w = (i >> 6) & 127, b = (int)(i >> 13);
        const bf16_t* zr = Z + (size_t)(b * TP + TP - 128 + w) * INW + c4 * 4;
        ((f32x4*)(p.out + O_KP))[((size_t)l * NB * 128 * 64) + i] = bf4(*(const u32x2*)(zr + ZK));
        ((f32x4*)(p.out + O_VP))[((size_t)l * NB * 128 * 64) + i] = bf4(*(const u32x2*)(zr + ZV));
    }
    for (size_t i = gt; i < (size_t)DBAT * 128 * 64; i += GT) {
        const int c4 = i & 63, w = (i >> 6) & 127, db = (int)(i >> 13);
        const int idx = w + DSEQ;
        f32x4 kv, vv;
        if (idx < 128) { const size_t o = (((size_t)l * DBAT + db) * 128 + idx) * 64 + c4; kv = ((const f32x4*)p.in[2])[o]; vv = ((const f32x4*)p.in[3])[o]; }
        else { const bf16_t* zr = Z + (size_t)(MP + db * DSEQ + idx - 128) * INW + c4 * 4; kv = bf4(*(const u32x2*)(zr + ZK)); vv = bf4(*(const u32x2*)(zr + ZV)); }
        ((f32x4*)(p.out + O_KS))[((size_t)l * DBAT * 128 * 64) + i] = kv;
        ((f32x4*)(p.out + O_VS))[((size_t)l * DBAT * 128 * 64) + i] = vv;
    }
    constexpr int NATT = NB * 17 * 2 + DBAT * 2, NREC = NB * 33 * 8 + 4 * 8;
    for (int it = blockIdx.x; it < NATT; it += gridDim.x) { attn_item(p, l, it, lds); __syncthreads(); }
    if (gridDim.x == 256) {
        const int bx = blockIdx.x; int first, cnt;
        if (bx < 136) { first = bx * 3; cnt = 3; } else if (bx < 200) { first = 408 + (bx - 136) * 5; cnt = 5; }
        else if (bx < 232) { first = 728 + (bx - 200) * 6; cnt = 6; } else { first = 920 + (bx - 232) * 7; cnt = 7; }
        RecIn cur, nxt; rec_load(p, l, first, cur);
        for (int k = 0; k < cnt; ++k) {
            if (k + 1 < cnt) rec_load(p, l, first + k + 1, nxt);
            rec_item(p, l, first + k, cur, lds); __syncthreads();
            cur = nxt;
        }
    } else {
        for (int it = blockIdx.x; it < NREC; it += gridDim.x) { RecIn cur; rec_load(p, l, it, cur); rec_item(p, l, it, cur, lds); __syncthreads(); }
    }
}

__device__ __forceinline__ void phase_mixB(PRM& p, int l, LAS unsigned char* lds) {
    const int tid = otid(), lane = tid & 63, wave = tid >> 6;
    LAS float* c_s = (LAS float*)lds;
    const unsigned* HA = (const unsigned*)(p.ws + WS_HLOC);
    bf16_t* MIX = (bf16_t*)(p.ws + WS_MIX);
    constexpr int NIT_P = NB * NGRP, NIT = NIT_P + MS / 16;
    const bool pair = gridDim.x == 256;
    float pc0 = 0.f, pc1 = 0.f; int pb = -1, pgrp = -1;
    for (int rep = 0; ; ++rep) {
        int it;
        if (pair) {
            const int x = blockIdx.x; if (rep > 2) break;
            if (x < 4) it = 3 * x + rep;
            else if (rep < 2) it = 12 + 2 * (x - 4) + rep;
            else { if (x >= 20) break; it = NIT_P + (x - 4); }
        } else it = blockIdx.x + rep * gridDim.x;
        if (it >= NIT) break;
        const bool samp = it >= NIT_P;
        int b = 0, grp = 0, R0;
        if (!samp) { b = it / NGRP; grp = it % NGRP; R0 = b * TP + grp * 16;
            const float* ga = (const float*)(p.ws + WS_AGGA) + (size_t)b * NGRP * LRUW; const float* gh = (const float*)(p.ws + WS_AGGH) + (size_t)b * NGRP * LRUW;
            const float* ca = (const float*)(p.ws + WS_AG64A) + (size_t)b * 33 * LRUW; const float* chh = (const float*)(p.ws + WS_AG64H) + (size_t)b * 33 * LRUW;
            float c0, c1;
            if (b == pb && grp == pgrp + 1) {
                const size_t o = (size_t)pgrp * LRUW + tid; c0 = ga[o] * pc0 + gh[o]; c1 = ga[o + 512] * pc1 + gh[o + 512];
            } else {
                const int n64 = grp >> 2; c0 = 0.f; c1 = 0.f;
#pragma unroll 16
                for (int g2 = 0; g2 < n64; ++g2) { const size_t o = (size_t)g2 * LRUW + tid; c0 = ca[o] * c0 + chh[o]; c1 = ca[o + 512] * c1 + chh[o + 512]; }
                for (int g2 = n64 * 4; g2 < grp; ++g2) { const size_t o = (size_t)g2 * LRUW + tid; c0 = ga[o] * c0 + gh[o]; c1 = ga[o + 512] * c1 + gh[o + 512]; }
            }
            pc0 = c0; pc1 = c1; pb = b; pgrp = grp;
            c_s[tid] = c0; c_s[1024 + tid] = c0; c_s[tid + 512] = c1; c_s[1024 + tid + 512] = c1;
        } else { const int j = it - NIT_P; R0 = MP + j * 16;
#pragma unroll
            for (int k = 0; k < 4; ++k) { const int e = tid + k * 512, half = e >> 10, ch = e & 1023; c_s[e] = p.in[5][((size_t)l * DBAT + j * 2 + half) * LRUW + ch]; } }
        __syncthreads();
        {
            const bf16_t* Zb = (const bf16_t*)(p.ws + WS_Z); const bf16_t* ATb = (const bf16_t*)(p.ws + WS_ATT);
            u32x2 aw[2][4], gw2[2][4]; u32x4 ha[2][4];
#pragma unroll
            for (int q = 0; q < 2; ++q) { const int row = R0 + wave * 2 + q;
#pragma unroll
                for (int j = 0; j < 4; ++j) { const int c0 = j * 256 + lane * 4;
                    aw[q][j] = *(const u32x2*)(ATb + (size_t)row * ATTW + c0); gw2[q][j] = *(const u32x2*)(Zb + (size_t)row * INW + ZG + c0);
                    ha[q][j] = *(const u32x4*)(HA + (size_t)row * LRUW + c0); } }
#pragma unroll
            for (int q = 0; q < 2; ++q) {
                const int r = wave * 2 + q, row = R0 + r;
                const LAS float* cs = c_s + ((samp && r >= 8) ? 1024 : 0);
                bool last; float* lout;
                if (!samp) { last = (grp * 16 + r) == TP - 1; lout = p.out + O_LP + ((size_t)l * NB + b) * LRUW; }
                else { last = (r & 7) == 7; lout = p.out + O_LS + ((size_t)l * DBAT + (row - MP) / 8) * LRUW; }
                f32x4 av[4], rv[4]; float ssa = 0.f, ssr = 0.f;
#pragma unroll
                for (int j = 0; j < 4; ++j) { const int c0 = j * 256 + lane * 4;
                    av[j] = bf4(aw[q][j]); const f32x4 gr = bf4(gw2[q][j]); const u32x4 hw_ = ha[q][j];
                    const f32x4 hlf = (f32x4){bflo(hw_.x), bflo(hw_.y), bflo(hw_.z), bflo(hw_.w)}, acf = (f32x4){bfhi(hw_.x), bfhi(hw_.y), bfhi(hw_.z), bfhi(hw_.w)};
                    f32x4 hh;
#pragma unroll
                    for (int e = 0; e < 4; ++e) { hh[e] = hlf[e] + acf[e] * cs[c0 + e]; rv[j][e] = hh[e] * gelu_tanh(gr[e]); ssa += av[j][e] * av[j][e]; ssr += rv[j][e] * rv[j][e]; }
                    if (last) *(f32x4*)(lout + c0) = hh; }
                const float ra = 1.f / sqrtf(wave_sum(ssa, lane) * (1.f / ATTW) + EPS), rr = 1.f / sqrtf(wave_sum(ssr, lane) * (1.f / LRUW) + EPS);
#pragma unroll
                for (int j = 0; j < 4; ++j) { const int c0 = j * 256 + lane * 4;
                    u32x2 w; w.x = pk2(av[j][0] * ra, av[j][1] * ra); w.y = pk2(av[j][2] * ra, av[j][3] * ra); *(u32x2*)(MIX + (size_t)row * D + c0) = w;
                    w.x = pk2(rv[j][0] * rr, rv[j][1] * rr); w.y = pk2(rv[j][2] * rr, rv[j][3] * rr); *(u32x2*)(MIX + (size_t)row * D + ATTW + c0) = w; }
            }
        }
        __syncthreads();
    }
}

constexpr int NPHASE = 1 + 8 * DEPTH;

__device__ __forceinline__ void run_phase(PRM& p, int ph, LAS unsigned char* lds) {
#ifndef EN_PREP
#define EN_PREP 1
#define EN_NORM 1
#define EN_GEMM 1
#define EN_MIXA 1
#define EN_MIXB 1
#endif
    if (ph == 0) { if (EN_PREP) phase_prep(p, lds); return; }
    const int l = (ph - 1) >> 3, s = (ph - 1) & 7;
    if (s == 0 || s == 3 || s == 5 || s == 6) {
        if (EN_GEMM) {
            pg8::Gemm g; pg8::Epi E; g.M = MPAD; E.R = nullptr;
            if (s == 0)      { g.A = (const bf16_t*)(p.ws + WS_U);   g.Bt = (const bf16_t*)(p.ws + WS_WIN) + (size_t)l * INW * D;  g.N = INW; g.K = D;   E.mode = 3; E.C = p.ws + WS_Z;   E.ldc = INW; }
            else if (s == 3) { g.A = (const bf16_t*)(p.ws + WS_MIX); g.Bt = (const bf16_t*)(p.ws + WS_WOUT) + (size_t)l * D * D;   g.N = D;   g.K = D;   E.mode = 1; E.C = p.ws + WS_H2;  E.R = (const bf16_t*)(p.ws + WS_H);  E.ldc = D; }
            else if (s == 5) { g.A = (const bf16_t*)(p.ws + WS_U);   g.Bt = (const bf16_t*)(p.ws + WS_WUP) + (size_t)l * DFF * D;  g.N = DFF; g.K = D;   E.mode = 2; E.C = p.ws + WS_HID; E.ldc = DFF; }
            else             { g.A = (const bf16_t*)(p.ws + WS_HID); g.Bt = (const bf16_t*)(p.ws + WS_WDN) + (size_t)l * D * DFF;  g.N = D;   g.K = DFF; E.mode = 1; E.C = p.ws + WS_H;   E.R = (const bf16_t*)(p.ws + WS_H2); E.ldc = D; }
            E.part = (float*)(p.ws + WS_PART);
            pg8::TailOrder S; S.init(MPAD, g.N, g.K, gridDim.x, blockIdx.x, E.mode == 1);
            pg8::gemm_phase(lds, g, S, E);
            if (s == 5 && gridDim.x == 256 && blockIdx.x >= 64) {
                constexpr int LATE = (D / 64) * (INW / 256) + (D / 64) * (D / 256) + (D / 64) * (DFF / 256);
                const int it0 = l * PREP_PER_L + LATE, it1 = (l + 1 < DEPTH) ? (l + 1) * PREP_PER_L + LATE : DEPTH * PREP_PER_L;
                prep_transposes(p, lds, it0, it1, blockIdx.x - 64, 192);
            }
        }
        return;
    }
    if (s == 1) { if (EN_MIXA) phase_mixA(p, l, lds); return; }
    if (s == 2) { if (EN_MIXB) phase_mixB(p, l, lds); return; }
    if (EN_NORM) phase_norm(p, s == 7 && l == DEPTH - 1, (gridDim.x == 256) ? (s == 4 ? 8 : 16) : 0, s == 4 ? WS_H : WS_H2, s == 4 ? WS_H2 : WS_H, lds);
}

#define XB_TMO      128
#define XB_XCNT(j)  (256  + 64 * (j))
#define XB_XSUB(j)  (1280 + 64 * (j))
#define XB_XGEN(j)  (2304 + 64 * (j))
#define XB_TOP      3328
#define XB_TOPGEN   3392
#define XCD_BAR_WORDS 3456
#define XB_SPIN_CAP (1u << 22)
__device__ __forceinline__ unsigned xb_ld(unsigned* p)              { return __hip_atomic_load(p, __ATOMIC_RELAXED, __HIP_MEMORY_SCOPE_AGENT); }
__device__ __forceinline__ unsigned xb_add(unsigned* p, unsigned v) { return __hip_atomic_fetch_add(p, v, __ATOMIC_RELAXED, __HIP_MEMORY_SCOPE_AGENT); }
__device__ __forceinline__ unsigned xb_xcc_id() { return (unsigned)__builtin_amdgcn_s_getreg((3 << 11) | 20) & 0xFu; }
#define XB_SPIN(cond, bar) do { unsigned _sp = 0; while (cond) { __builtin_amdgcn_s_sleep(1); \
    if ((++_sp & 255u) == 0u) { if (xb_ld(&(bar)[XB_TMO])) break; if (_sp > XB_SPIN_CAP) { atomicAdd(&(bar)[XB_TMO], 1u); break; } } } } while (0)
struct XcdBarrier { unsigned* bar; unsigned x; volatile LAS unsigned* st; };
__device__ __forceinline__ XcdBarrier xcd_barrier_post(unsigned* bar, volatile LAS unsigned* st) {
    XcdBarrier b; b.bar = bar; b.x = xb_xcc_id(); b.st = st;
    if (threadIdx.x == 0) (void)xb_add(&bar[XB_XCNT(b.x)], 1u);
    return b;
}
__device__ __forceinline__ void xcd_barrier_complete(unsigned* bar, unsigned x, unsigned& nloc, unsigned& nx) {
    const unsigned G = gridDim.x * gridDim.y * gridDim.z;
    unsigned sum, cnt, mine, sp = 0u;
    for (;;) {
        sum = 0u; cnt = 0u; mine = 0u;
#pragma unroll
        for (unsigned j = 0; j < 16; ++j) { const unsigned c = xb_ld(&bar[XB_XCNT(j)]); sum += c; cnt += (c > 0u) ? 1u : 0u; mine = (j == x) ? c : mine; }
        if (sum == G) break;
        __builtin_amdgcn_s_sleep(1);
        if ((++sp & 255u) == 0u) { if (xb_ld(&bar[XB_TMO])) break; if (sp > XB_SPIN_CAP) { atomicAdd(&bar[XB_TMO], 1u); break; } }
    }
    nloc = mine > 0u ? mine : 1u; nx = cnt > 0u ? cnt : 1u;
}
__device__ __forceinline__ void xcd_barrier(const XcdBarrier& b) {
    asm volatile("s_waitcnt vmcnt(0)" ::: "memory");
    __syncthreads();
    if (otid() == 0) {
        unsigned* bar = b.bar;
        __builtin_amdgcn_s_waitcnt(0);
        unsigned nloc = b.st[0], nx = b.st[1];
        if (nloc == 0u) { xcd_barrier_complete(bar, b.x, nloc, nx); b.st[0] = nloc; b.st[1] = nx; }
        const unsigned old = xb_add(&bar[XB_XSUB(b.x)], 1u);
        const unsigned gen = old / nloc;
        if (old + 1u == (gen + 1u) * nloc) {
            __builtin_amdgcn_fence(__ATOMIC_RELEASE, "agent");
            asm volatile("s_waitcnt vmcnt(0)" ::: "memory");
            const unsigned og = xb_add(&bar[XB_TOP], 1u);
            const unsigned tg = og / nx;
            if (og + 1u == (tg + 1u) * nx) xb_add(&bar[XB_TOPGEN], 1u);
            else XB_SPIN(xb_ld(&bar[XB_TOPGEN]) == tg, bar);
            __builtin_amdgcn_fence(__ATOMIC_ACQUIRE, "agent");
            xb_add(&bar[XB_XGEN(b.x)], 1u);
            asm volatile("s_waitcnt vmcnt(0)" ::: "memory");
        } else {
            XB_SPIN(xb_ld(&bar[XB_XGEN(b.x)]) == gen, bar);
            __builtin_amdgcn_fence(__ATOMIC_ACQUIRE, "agent");
            asm volatile("s_waitcnt vmcnt(0)" ::: "memory");
        }
    }
    __syncthreads();
}

__device__ __forceinline__ void grid_bar(unsigned* ctr, unsigned target) {
    asm volatile("s_waitcnt vmcnt(0) lgkmcnt(0)" ::: "memory");
    __syncthreads();
    if (otid() == 0) {
        __builtin_amdgcn_fence(__ATOMIC_RELEASE, "agent");
        asm volatile("s_waitcnt vmcnt(0)" ::: "memory");
        __hip_atomic_fetch_add(ctr, 1u, __ATOMIC_RELAXED, __HIP_MEMORY_SCOPE_AGENT);
        while (__hip_atomic_load(ctr, __ATOMIC_RELAXED, __HIP_MEMORY_SCOPE_AGENT) < target) __builtin_amdgcn_s_sleep(2);
        __builtin_amdgcn_fence(__ATOMIC_ACQUIRE, "agent");
        asm volatile("s_waitcnt vmcnt(0)" ::: "memory");
    }
    __syncthreads();
}

__global__ void __launch_bounds__(512, 2) hymba_fwd(Params p) {
    extern __shared__ __attribute__((aligned(16))) unsigned char shm[];
    LAS unsigned char* lds = (LAS unsigned char*)shm;
    volatile LAS unsigned* bst = (volatile LAS unsigned*)(lds + LDS_BYTES - 16);
    if (otid() < 2) bst[otid()] = 0u;
    __syncthreads();
    XcdBarrier xbar; xbar.bar = (unsigned*)(p.ws + WS_BAR) + 64; xbar.x = 0; xbar.st = bst;
    if (p.ph_hi - p.ph_lo > 1) {
        xbar = xcd_barrier_post((unsigned*)(p.ws + WS_BAR) + 64, bst);
        if (p.ph_lo < 0) cg::this_grid().sync();
    }
    unsigned nbar = 0;
    for (int ph = p.ph_lo; ph < p.ph_hi; ++ph) {
        PRM* pp = (PRM*)__builtin_amdgcn_kernarg_segment_ptr(); asm volatile("" : "+s"(pp));
        run_phase(*pp, ph, lds);
#if defined(PROBE_REPEAT)
        { const int kind = ph < 1 ? 100 + ph : ((ph - 1) & 7);
          if (kind == PROBE_REPEAT) { ++nbar; grid_bar((unsigned*)(pp->ws + WS_BAR), nbar * gridDim.x); run_phase(*pp, ph, lds); }
          if (PROBE_REPEAT == 200 && ph >= 2) for (int r = 0; r < 4; ++r) { ++nbar; grid_bar((unsigned*)(pp->ws + WS_BAR), nbar * gridDim.x); } }
#endif
        if (ph + 1 < p.ph_hi) xcd_barrier(xbar);
    }
}

extern "C" void kernel_launch(void* const* d_in, const int* in_sizes, int n_in, void* d_out, int out_size, void* d_ws, size_t ws_size, hipStream_t stream) {
    static int grid = 0;
    if (grid == 0) {
        if (n_in != 25 || (size_t)out_size != O_END || ws_size < WS_END) { fprintf(stderr, "kernel_launch: unexpected shapes: n_in %d out %d ws %zu (need %zu)\n", n_in, out_size, ws_size, (size_t)WS_END); grid = -1; return; }
        int dev = 0, cus = 0, per_cu = 0;
        hipGetDevice(&dev); hipDeviceGetAttribute(&cus, hipDeviceAttributeMultiprocessorCount, dev);
        if (hipFuncSetAttribute((const void*)hymba_fwd, hipFuncAttributeMaxDynamicSharedMemorySize, LDS_BYTES) != hipSuccess) { fprintf(stderr, "kernel_launch: hipFuncSetAttribute failed\n"); grid = -1; return; }
        hipOccupancyMaxActiveBlocksPerMultiprocessor(&per_cu, (const void*)hymba_fwd, NTHREADS, LDS_BYTES);
        if (per_cu < 1) { fprintf(stderr, "kernel_launch: occupancy query says %d blocks per CU\n", per_cu); per_cu = 1; }
        (void)hipGetLastError();
        grid = cus * 1;
    }
    if (grid < 0) return;
    Params p{};
    for (int i = 0; i < 25; ++i) p.in[i] = (const float*)d_in[i];
    p.out = (float*)d_out; p.ws = (unsigned char*)d_ws;
#if MK_SINGLE
    hipMemsetAsync((char*)d_ws + WS_BAR, 0, 256 + XCD_BAR_WORDS_C * 4, stream);
    p.ph_lo = 0; p.ph_hi = NPHASE;
    void* args[] = {&p};
    hipError_t e = hipLaunchCooperativeKernel((const void*)hymba_fwd, dim3(grid), dim3(NTHREADS), args, LDS_BYTES, stream);
    if (e != hipSuccess) fprintf(stderr, "cooperative launch failed: %s (grid %d)\n", hipGetErrorString(e), grid);
#else
    for (int ph = 0; ph < NPHASE; ++ph) {
        p.ph_lo = ph; p.ph_hi = ph + 1;
        hipLaunchKernelGGL(hymba_fwd, dim3(grid), dim3(NTHREADS), LDS_BYTES, stream, p);
    }
#endif
}
```
